# Optimizing an MI355X kernel written in HIP

```python
import math
import jax
import jax.numpy as jnp
from jax import lax
import numpy as np

D_MODEL = 1024
BATCH = 8
SEQ = 4096
DEPTH = 2

HEAD_DIM = 64
BRANCH_WIDTH = 256
N_MIXERS = 4
NSA_Q_HEADS = 4
NSA_KV_HEADS = 2
NSA_GROUP = NSA_Q_HEADS // NSA_KV_HEADS
NSA_CMP_LEN = 32
NSA_CMP_STRIDE = 16
NSA_SEL_LEN = 64
NSA_SEL_TOPN = 16
NSA_WINDOW = 512
NSA_SEL_QBLOCK = 32
NSA_WIN_QBLOCK = 128
NSA_FORCE_SCORE = 1.0e4
SC_WIDTH = BRANCH_WIDTH
SC_CONV_LEN = 3
SB_HEADS = 4
SB_WIDTH = SB_HEADS * HEAD_DIM
SB_QBLOCK = 128
S5_WIDTH = BRANCH_WIDTH
S5_GROUP_CH = 16
S5_GROUPS = S5_WIDTH // S5_GROUP_CH
S5_STATE = 64

ROPE_THETA = 10000.0
NORM_EPS = 1e-6
POS_OFFSET_MAX = 1024

PROJ_SIZES = (
    NSA_Q_HEADS * HEAD_DIM,
    3 * 2 * NSA_KV_HEADS * HEAD_DIM,
    3 * NSA_Q_HEADS,
    BRANCH_WIDTH,
    3 * SC_WIDTH,
    BRANCH_WIDTH,
    3 * SB_WIDTH,
    BRANCH_WIDTH,
    S5_WIDTH,
    BRANCH_WIDTH,
    N_MIXERS * D_MODEL,
)
IN_PROJ_WIDTH = sum(PROJ_SIZES)

kernel_name = "hybrid_nsa_shortconv_stickbreak_s5"


def rms_norm(x, g):
    xf = x.astype(jnp.float32)
    y = xf * lax.rsqrt(jnp.mean(xf * xf, axis=-1, keepdims=True) + NORM_EPS)
    return (y * g.astype(jnp.float32)).astype(x.dtype)


def rope(x, pos):
    half = HEAD_DIM // 2
    inv_freq = jnp.power(ROPE_THETA, -jnp.arange(half, dtype=jnp.float32) / half)
    ang = pos.astype(jnp.float32)[..., None] * inv_freq
    ang = ang.reshape(ang.shape[:2] + (1,) * (x.ndim - 3) + (half,))
    cos, sin = jnp.cos(ang), jnp.sin(ang)
    xf = x.astype(jnp.float32)
    x1, x2 = xf[..., :half], xf[..., half:]
    return jnp.concatenate([x1 * cos - x2 * sin, x2 * cos + x1 * sin], axis=-1).astype(x.dtype)


def masked_softmax(scores, mask):
    s = jnp.where(mask, scores.astype(jnp.float32), -jnp.inf)
    m = jnp.max(s, axis=-1, keepdims=True)
    m = jnp.where(jnp.isfinite(m), m, 0.0)
    e = jnp.where(mask, jnp.exp(s - m), 0.0)
    return e / jnp.maximum(jnp.sum(e, axis=-1, keepdims=True), 1e-30)


def nsa_mixer(q_in, kv_in, gate_in, positions, qk_g, cmp_pe, cmp_w1, cmp_w2):
    b, s, _ = q_in.shape
    kh, grp, dh = NSA_KV_HEADS, NSA_GROUP, HEAD_DIM
    scale = dh ** -0.5
    t_idx = jnp.arange(s)
    q = rope(rms_norm(q_in.reshape(b, s, kh, grp, dh), qk_g[0]), positions)
    kv = kv_in.reshape(b, s, 3, 2, kh, dh)
    k_c, v_c = kv[:, :, 0, 0], kv[:, :, 0, 1]
    k_s = rope(rms_norm(kv[:, :, 1, 0], qk_g[2]), positions)
    v_s = kv[:, :, 1, 1]
    k_w = rope(rms_norm(kv[:, :, 2, 0], qk_g[3]), positions)
    v_w = kv[:, :, 2, 1]

    n_cmp = (s - NSA_CMP_LEN) // NSA_CMP_STRIDE + 1
    cmp_start = jnp.arange(n_cmp) * NSA_CMP_STRIDE
    cmp_end = cmp_start + NSA_CMP_LEN - 1
    blk_idx = cmp_start[:, None] + jnp.arange(NSA_CMP_LEN)[None, :]

    def compress(t, j):
        blk = t[:, blk_idx] + cmp_pe[j][None, None, :, None, :]
        blk = jnp.moveaxis(blk, 3, 2).reshape(b, n_cmp, kh, NSA_CMP_LEN * dh)
        return jax.nn.silu(blk @ cmp_w1[j]) @ cmp_w2[j]

    k_cmp = rope(rms_norm(compress(k_c, 0), qk_g[1]), positions[:, cmp_end])
    v_cmp = compress(v_c, 1)
    sc_cmp = jnp.einsum('bskgd,bnkd->bkgsn', q, k_cmp).astype(jnp.float32) * scale
    p_cmp = masked_softmax(sc_cmp, cmp_end[None, :] <= t_idx[:, None])
    o_cmp = jnp.einsum('bkgsn,bnkd->bskgd', p_cmp.astype(v_cmp.dtype), v_cmp)

    n_sel = s // NSA_SEL_LEN
    sel_start = jnp.arange(n_sel) * NSA_SEL_LEN
    overlap = ((cmp_start[:, None] < sel_start[None, :] + NSA_SEL_LEN)
               & (cmp_start[:, None] + NSA_CMP_LEN > sel_start[None, :])).astype(jnp.float32)
    imp = jnp.einsum('bkgsn,nj->bskj', p_cmp, overlap)
    cur = t_idx // NSA_SEL_LEN
    jb = jnp.arange(n_sel)
    forced = (jb[None, :] == 0) | (jb[None, :] == cur[:, None]) | (jb[None, :] == cur[:, None] - 1)
    valid = sel_start[None, :] <= t_idx[:, None]
    imp = jnp.where(forced[None, :, None, :], NSA_FORCE_SCORE,
                    jnp.where(valid[None, :, None, :], imp, -NSA_FORCE_SCORE))
    top_n = min(NSA_SEL_TOPN, n_sel)
    _, sel_idx = lax.top_k(imp, top_n)

    k_blk = k_s.reshape(b, n_sel, NSA_SEL_LEN, kh, dh).transpose(0, 3, 1, 2, 4)
    v_blk = v_s.reshape(b, n_sel, NSA_SEL_LEN, kh, dh).transpose(0, 3, 1, 2, 4)
    qbs = NSA_SEL_QBLOCK
    nq = s // qbs
    q_b = jnp.moveaxis(q.reshape(b, nq, qbs, kh, grp, dh), 1, 0)
    i_b = jnp.moveaxis(sel_idx.reshape(b, nq, qbs, kh, top_n), 1, 0)
    t_b = t_idx.reshape(nq, qbs)
    bi = jnp.arange(b)[:, None, None, None]
    hi = jnp.arange(kh)[None, None, :, None]
    n_keys = top_n * NSA_SEL_LEN

    def sel_block(args):
        qb, ib, tb = args
        kg = k_blk[bi, hi, ib].reshape(b, qbs, kh, n_keys, dh)
        vg = v_blk[bi, hi, ib].reshape(b, qbs, kh, n_keys, dh)
        pos = (ib[..., None] * NSA_SEL_LEN + jnp.arange(NSA_SEL_LEN)).reshape(b, qbs, kh, n_keys)
        mask = (pos <= tb[None, :, None, None]).transpose(0, 2, 1, 3)[:, :, None]
        sc = jnp.einsum('bqkgd,bqkmd->bkgqm', qb, kg).astype(jnp.float32) * scale
        p = masked_softmax(sc, mask)
        return jnp.einsum('bkgqm,bqkmd->bqkgd', p.astype(vg.dtype), vg)

    o_slc = jnp.moveaxis(lax.map(sel_block, (q_b, i_b, t_b)), 0, 1).reshape(b, s, kh, grp, dh)

    qbw = NSA_WIN_QBLOCK
    nw = s // qbw
    kp = jnp.pad(k_w, ((0, 0), (NSA_WINDOW, 0), (0, 0), (0, 0)))
    vp = jnp.pad(v_w, ((0, 0), (NSA_WINDOW, 0), (0, 0), (0, 0)))
    q_w = jnp.moveaxis(q.reshape(b, nw, qbw, kh, grp, dh), 1, 0)
    w_starts = jnp.arange(nw) * qbw

    def win_block(args):
        qb, start = args
        kb = lax.dynamic_slice_in_dim(kp, start, NSA_WINDOW + qbw, axis=1)
        vb = lax.dynamic_slice_in_dim(vp, start, NSA_WINDOW + qbw, axis=1)
        tq = start + jnp.arange(qbw)
        tk = start - NSA_WINDOW + jnp.arange(NSA_WINDOW + qbw)
        mask = (tk[None, :] <= tq[:, None]) & (tk[None, :] > tq[:, None] - NSA_WINDOW) & (tk[None, :] >= 0)
        sc = jnp.einsum('bqkgd,bmkd->bkgqm', qb, kb).astype(jnp.float32) * scale
        p = masked_softmax(sc, mask)
        return jnp.einsum('bkgqm,bmkd->bqkgd', p.astype(vb.dtype), vb)

    o_win = jnp.moveaxis(lax.map(win_block, (q_w, w_starts)), 0, 1).reshape(b, s, kh, grp, dh)

    g = jax.nn.sigmoid(gate_in).reshape(b, s, 3, kh, grp)[..., None]
    o = g[:, :, 0] * o_cmp + g[:, :, 1] * o_slc + g[:, :, 2] * o_win
    return o.reshape(b, s, NSA_Q_HEADS * dh)


def short_conv_mixer(bcx, conv_w):
    bg, cg, xin = jnp.split(bcx, 3, axis=-1)
    u = cg * xin
    y = lax.conv_general_dilated(u, conv_w[:, None, :], window_strides=(1,),
                                 padding=[(SC_CONV_LEN - 1, 0)],
                                 dimension_numbers=('NWC', 'WIO', 'NWC'),
                                 feature_group_count=SC_WIDTH)
    return bg * y


def stick_breaking_mixer(qkv):
    b, s, _ = qkv.shape
    t = qkv.reshape(b, s, 3, SB_HEADS, HEAD_DIM)
    q, k, v = t[:, :, 0], t[:, :, 1], t[:, :, 2]
    scale = HEAD_DIM ** -0.5
    nq = s // SB_QBLOCK
    q_b = jnp.moveaxis(q.reshape(b, nq, SB_QBLOCK, SB_HEADS, HEAD_DIM), 1, 0)
    q_starts = jnp.arange(nq) * SB_QBLOCK
    t_k = jnp.arange(s)

    def block(args):
        qb, start = args
        z = jnp.einsum('bqhd,bshd->bhqs', qb, k).astype(jnp.float32) * scale
        tq = start + jnp.arange(SB_QBLOCK)
        mask = t_k[None, :] < tq[:, None]
        log_1mb = jnp.where(mask, jax.nn.log_sigmoid(-z), 0.0)
        after = lax.cumsum(log_1mb, axis=3, reverse=True) - log_1mb
        w = jnp.where(mask, jnp.exp(jax.nn.log_sigmoid(z) + after), 0.0)
        return jnp.einsum('bhqs,bshd->bqhd', w.astype(v.dtype), v)

    o = jnp.moveaxis(lax.map(block, (q_b, q_starts)), 0, 1)
    return o.reshape(b, s, SB_WIDTH)


def _ssm_combine(e1, e2):
    a1r, a1i, b1r, b1i = e1
    a2r, a2i, b2r, b2i = e2
    return (a2r * a1r - a2i * a1i,
            a2r * a1i + a2i * a1r,
            a2r * b1r - a2i * b1i + b2r,
            a2r * b1i + a2i * b1r + b2i)


def s5_mixer(u, a_re, a_im, log_dt, b_re, b_im, c_re, c_im, d_skip, glu_w, glu_b):
    f32 = jnp.float32
    bsz, s, _ = u.shape
    ug = u.reshape(bsz, s, S5_GROUPS, S5_GROUP_CH).astype(f32)
    dt = jnp.exp(log_dt.astype(f32))[:, None]
    lr, li = a_re.astype(f32), a_im.astype(f32)
    mag = jnp.exp(lr * dt)
    ab_re, ab_im = mag * jnp.cos(li * dt), mag * jnp.sin(li * dt)
    den = lr * lr + li * li
    coef_re = ((ab_re - 1.0) * lr + ab_im * li) / den
    coef_im = (ab_im * lr - (ab_re - 1.0) * li) / den
    br, bim = b_re.astype(f32), b_im.astype(f32)
    bb_re = coef_re[..., None] * br - coef_im[..., None] * bim
    bb_im = coef_re[..., None] * bim + coef_im[..., None] * br
    bu_re = jnp.einsum('gpc,bsgc->bsgp', bb_re, ug)
    bu_im = jnp.einsum('gpc,bsgc->bsgp', bb_im, ug)
    a_r = jnp.broadcast_to(ab_re, bu_re.shape)
    a_i = jnp.broadcast_to(ab_im, bu_re.shape)
    _, _, x_re, x_im = lax.associative_scan(_ssm_combine, (a_r, a_i, bu_re, bu_im), axis=1)
    y = (jnp.einsum('gcp,bsgp->bsgc', c_re.astype(f32), x_re)
         - jnp.einsum('gcp,bsgp->bsgc', c_im.astype(f32), x_im)
         + d_skip.astype(f32) * ug)
    y = y.reshape(bsz, s, S5_WIDTH).astype(u.dtype)
    a, g = jnp.split(y @ glu_w + glu_b, 2, axis=-1)
    return a * jax.nn.sigmoid(g)


def setup_inputs(seed: int = 0) -> dict:
    key = jax.random.key(seed)
    ks = iter(jax.random.split(key, 32))
    f32 = jnp.float32
    L, dh = DEPTH, HEAD_DIM

    def nrm(shape, scale):
        return jax.random.normal(next(ks), shape, f32) * scale

    x = nrm((BATCH, SEQ, D_MODEL), 1.0)
    positions = (jnp.arange(SEQ, dtype=jnp.int32)[None, :]
                 + jax.random.randint(next(ks), (BATCH, 1), 0, POS_OFFSET_MAX, dtype=jnp.int32))
    norm_g = 1.0 + nrm((L, D_MODEL), 0.02)
    w_in = nrm((L, D_MODEL, IN_PROJ_WIDTH), D_MODEL ** -0.5)
    nsa_qk_g = 1.0 + nrm((L, 4, dh), 0.02)
    nsa_cmp_pe = nrm((L, 2, NSA_CMP_LEN, dh), 0.1)
    nsa_cmp_w1 = nrm((L, 2, NSA_CMP_LEN * dh, dh), (NSA_CMP_LEN * dh) ** -0.5)
    nsa_cmp_w2 = nrm((L, 2, dh, dh), dh ** -0.5)
    sc_conv_w = nrm((L, SC_CONV_LEN, SC_WIDTH), SC_CONV_LEN ** -0.5)
    n_idx = jnp.arange(S5_STATE, dtype=f32)
    s5_a_re = -0.5 + nrm((L, S5_GROUPS, S5_STATE), 0.01)
    s5_a_im = math.pi * n_idx + nrm((L, S5_GROUPS, S5_STATE), 0.01)
    s5_log_dt = jax.random.uniform(next(ks), (L, S5_GROUPS), f32, math.log(1e-3), math.log(1e-1))
    s5_b_re = nrm((L, S5_GROUPS, S5_STATE, S5_GROUP_CH), (2 * S5_GROUP_CH) ** -0.5)
    s5_b_im = nrm((L, S5_GROUPS, S5_STATE, S5_GROUP_CH), (2 * S5_GROUP_CH) ** -0.5)
    s5_c_re = nrm((L, S5_GROUPS, S5_GROUP_CH, S5_STATE), 0.5)
    s5_c_im = nrm((L, S5_GROUPS, S5_GROUP_CH, S5_STATE), 0.5)
    s5_d = nrm((L, S5_GROUPS, S5_GROUP_CH), 0.5)
    s5_glu_w = nrm((L, S5_WIDTH, 2 * S5_WIDTH), S5_WIDTH ** -0.5)
    s5_glu_b = nrm((L, 2 * S5_WIDTH), 0.01)
    w_branch = nrm((L, N_MIXERS, BRANCH_WIDTH, D_MODEL), BRANCH_WIDTH ** -0.5)
    w_out = nrm((L, D_MODEL, D_MODEL), D_MODEL ** -0.5)
    return {"x": x, "positions": positions, "norm_g": norm_g, "w_in": w_in,
            "nsa_qk_g": nsa_qk_g, "nsa_cmp_pe": nsa_cmp_pe, "nsa_cmp_w1": nsa_cmp_w1,
            "nsa_cmp_w2": nsa_cmp_w2, "sc_conv_w": sc_conv_w, "s5_a_re": s5_a_re,
            "s5_a_im": s5_a_im, "s5_log_dt": s5_log_dt, "s5_b_re": s5_b_re, "s5_b_im": s5_b_im,
            "s5_c_re": s5_c_re, "s5_c_im": s5_c_im, "s5_d": s5_d, "s5_glu_w": s5_glu_w,
            "s5_glu_b": s5_glu_b, "w_branch": w_branch, "w_out": w_out}


def reference(x, positions, norm_g, w_in, nsa_qk_g, nsa_cmp_pe, nsa_cmp_w1, nsa_cmp_w2,
              sc_conv_w, s5_a_re, s5_a_im, s5_log_dt, s5_b_re, s5_b_im, s5_c_re, s5_c_im,
              s5_d, s5_glu_w, s5_glu_b, w_branch, w_out):
    b, s, _ = x.shape
    split_at = [int(o) for o in np.cumsum(PROJ_SIZES)[:-1]]
    for l in range(DEPTH):
        h = rms_norm(x, norm_g[l])
        proj = h @ w_in[l]
        (nsa_q, nsa_kv, nsa_gate, nsa_z, sc_bcx, sc_z, sb_qkv, sb_z,
         s5_u, s5_z, merge) = jnp.split(proj, split_at, axis=-1)
        outs = (
            nsa_mixer(nsa_q, nsa_kv, nsa_gate, positions, nsa_qk_g[l], nsa_cmp_pe[l],
                      nsa_cmp_w1[l], nsa_cmp_w2[l]) * jax.nn.silu(nsa_z),
            short_conv_mixer(sc_bcx, sc_conv_w[l]) * jax.nn.silu(sc_z),
            stick_breaking_mixer(sb_qkv) * jax.nn.silu(sb_z),
            s5_mixer(s5_u, s5_a_re[l], s5_a_im[l], s5_log_dt[l], s5_b_re[l], s5_b_im[l],
                     s5_c_re[l], s5_c_im[l], s5_d[l], s5_glu_w[l], s5_glu_b[l]) * jax.nn.silu(s5_z),
        )
        gates = jax.nn.sigmoid(merge).reshape(b, s, N_MIXERS, D_MODEL)
        mixed = gates[:, :, 0] * (outs[0] @ w_branch[l, 0])
        for m in range(1, N_MIXERS):
            mixed = mixed + gates[:, :, m] * (outs[m] @ w_branch[l, m])
        x = x + mixed @ w_out[l]
    return x
```

```cpp
#include <hip/hip_runtime.h>
#include <hip/hip_cooperative_groups.h>
#include <cstdio>
#include <cstdint>
namespace cg = cooperative_groups;

#define DI __device__ __forceinline__
#define LAS __attribute__((address_space(3)))
typedef unsigned short bf16_t;
typedef short bf16x8 __attribute__((ext_vector_type(8)));
typedef short s16x4 __attribute__((ext_vector_type(4)));
typedef float f32x4 __attribute__((ext_vector_type(4)));
typedef float f32x2 __attribute__((ext_vector_type(2)));
typedef float f32x16 __attribute__((ext_vector_type(16)));
typedef unsigned u32x4 __attribute__((ext_vector_type(4)));
typedef unsigned u32x2 __attribute__((ext_vector_type(2)));
typedef __bf16 bf16x2_t __attribute__((ext_vector_type(2)));

constexpr int S = 4096, NBH = 4, TH = NBH * S, DM = 1024, NP = 3840, NGATE = 4096, NINW = 7948, NIN = 7936, NINP = 8192;
constexpr int C_NQ = 0, C_NKV = 256, C_NZ = 1024, C_SC = 1280, C_SCZ = 2048, C_SB = 2304, C_SBZ = 3072, C_S5U = 3328, C_S5Z = 3584;
constexpr float EPS = 1e-6f, LOG2E = 1.4426950408889634f;
constexpr int NWAVES = 8, NTHR = 512, LDS_BYTES = 147456;

constexpr size_t MiB = 1u << 20;
constexpr size_t WS_CTL = 0, CTL_BYTES = 128 * 1024;
constexpr size_t WS_WINT = 1 * MiB, WS_WBT = 33 * MiB, WS_WOUTT = 37 * MiB, WS_GLUT = 41 * MiB, WS_CW1T = 42 * MiB;
constexpr size_t WS_POW = 43 * MiB, WS_BBAR = 45 * MiB, WS_KMAT = 46 * MiB, WS_SPG = 48 * MiB, WS_SA2 = 56 * MiB;
constexpr size_t WS_XB = 92 * MiB, WS_RSTD = 124 * MiB, WS_G12 = 125 * MiB, WS_PROJ = 126 * MiB, WS_GATES = 246 * MiB;
constexpr size_t WS_QN = 374 * MiB, WS_KS = 382 * MiB, WS_KW = 386 * MiB, WS_VTS = 390 * MiB, WS_VTW = 394 * MiB, WS_VTB = 398 * MiB;
constexpr size_t WS_KC = 406 * MiB, WS_VCT = 406 * MiB + 512 * 1024, WS_SEL = 407 * MiB, WS_OCMP = 408 * MiB, WS_OWIN = 416 * MiB;
constexpr size_t WS_OUTS = 424 * MiB, WS_UX = 456 * MiB, WS_STL = 466 * MiB, WS_Y5 = 470 * MiB, WS_KB = 478 * MiB, WS_WB2T = 486 * MiB, WS_END = 494 * MiB;
constexpr size_t WS_TMP = WS_PROJ, WS_MIXED = WS_XB;

DI float bf2f(bf16_t v) { return __uint_as_float(((unsigned)v) << 16); }
DI unsigned cvtpk(float lo, float hi) { f32x2 v = {lo, hi}; bf16x2_t b = __builtin_convertvector(v, bf16x2_t); return __builtin_bit_cast(unsigned, b); }
DI bf16_t f2bf(float f) { return (bf16_t)(cvtpk(f, 0.f) & 0xffffu); }
DI float wave_sum(float v) {
#pragma unroll
    for (int o = 1; o < 64; o <<= 1) v += __shfl_xor(v, o);
    return v;
}
DI float sigm(float x) { return __builtin_amdgcn_rcpf(1.f + __builtin_amdgcn_exp2f(x * -1.4426950408889634f)); }
DI float ex2(float x) { return __builtin_amdgcn_exp2f(x); }
DI float lg2(float x) { return __builtin_amdgcn_logf(x); }
DI void sincos_acc(float ang, float& s, float& c) {
    double rev = (double)ang * 0.15915494309189535; float fr = (float)(rev - floor(rev));
    s = __builtin_amdgcn_sinf(fr); c = __builtin_amdgcn_cosf(fr);
}
DI void unpack8(u32x4 w, float (&f)[8]) {
    f[0] = __uint_as_float(w.x << 16); f[1] = __uint_as_float(w.x & 0xffff0000u); f[2] = __uint_as_float(w.y << 16); f[3] = __uint_as_float(w.y & 0xffff0000u);
    f[4] = __uint_as_float(w.z << 16); f[5] = __uint_as_float(w.z & 0xffff0000u); f[6] = __uint_as_float(w.w << 16); f[7] = __uint_as_float(w.w & 0xffff0000u);
}
DI void unpack4(u32x2 w, float (&f)[4]) {
    f[0] = __uint_as_float(w.x << 16); f[1] = __uint_as_float(w.x & 0xffff0000u); f[2] = __uint_as_float(w.y << 16); f[3] = __uint_as_float(w.y & 0xffff0000u);
}
#define LDS_WAIT() asm volatile("s_waitcnt lgkmcnt(0)" ::: "memory")
#define VM_WAIT() asm volatile("s_waitcnt vmcnt(0)" ::: "memory")

namespace pg8 {
constexpr int BM = 256, BK = 64, HALF = 128, HTB = HALF * BK * 2, NXCD = 8, WGM = 8;
DI int lds_byte(int r, int c) { const int st = (r >> 4) * 2 + (c >> 5), rr = r & 15, cc = c & 31, ob = rr * 64 + cc * 2; return st * 1024 + (ob ^ (((ob >> 9) & 1) << 5)); }
DI void stage_rc(int b, int& R, int& C) { const int st = b / 1024, sb = b % 1024, swz = sb ^ (((sb >> 9) & 1) << 5); R = (st >> 1) * 16 + swz / 64; C = (st & 1) * 32 + (swz % 64) / 2; }
DI int perm32(int rho) { const int n = rho >> 4, i = rho & 15; return 8 * (i >> 2) + 4 * n + (i & 3); }
struct Unit { int pm, pn, z; };
struct Gemm { const bf16_t* A; const bf16_t* Bt; };
template <int LDA_, int LDB_, int K_, long SAZ_, long SBZ_, int NM_, int NN_, int NZ_, int MODE_, bool HK_ = false> struct Cfg { static constexpr int LDA = LDA_, LDB = LDB_, K = K_, NM = NM_, NN = NN_, NZ = NZ_, MODE = MODE_; static constexpr long SAZ = SAZ_, SBZ = SBZ_; static constexpr bool HK = HK_; };
DI void tile_map(int wgid, int nM, int nN, int& pm, int& pn) {
    const int nwg = nM * nN; { const int q = nwg / NXCD, r = nwg % NXCD, xcd = wgid % NXCD, off = wgid / NXCD; wgid = (xcd < r ? xcd * (q + 1) : r * (q + 1) + (xcd - r) * q) + off; }
    const int nig = WGM * nN, gid = wgid / nig, fm = gid * WGM, gsz = (nM - fm) < WGM ? (nM - fm) : WGM;
    pm = fm + ((wgid % nig) % gsz); pn = (wgid % nig) / gsz;
}
template <class C> struct Sched {
    int G, c;
    DI bool next(int i, Unit& u) const {
        constexpr int per = C::NM * C::NN;
        if (C::MODE == 2) { if (i >= C::NN) return false; u.z = c; u.pm = 0; u.pn = i; return true; }
        if (C::MODE == 0) { const int L = i * G + c; if (L >= per * C::NZ) return false; const int z = L / per, r = L % per; u.z = z;
            if (C::NZ == 1) tile_map(r, C::NM, C::NN, u.pm, u.pn); else { u.pm = r % C::NM; u.pn = r / C::NM; } return true; }
        const int t = (i / C::NZ) * G + c; if (t >= per) return false; u.z = i % C::NZ; tile_map(t, C::NM, C::NN, u.pm, u.pn); return true;
    }
};
template <class C> DI const char* unitA(const Gemm& g, const Unit& u) { return (const char*)g.A + ((size_t)u.z * C::SAZ + (size_t)u.pm * BM * C::LDA) * 2; }
template <class C> DI const char* unitB(const Gemm& g, const Unit& u) { return (const char*)g.Bt + ((size_t)u.z * C::SBZ + (size_t)u.pn * BM * C::LDB) * 2; }

template <class C, class Epi>
DI void gemm_phase(LAS unsigned char* lds, const Gemm g, const Sched<C>& S, const Epi& E) {
    int tid_ = threadIdx.x; asm volatile("" : "+v"(tid_));
    const int tid = tid_, wid = __builtin_amdgcn_readfirstlane(tid >> 6), lane = tid & 63, wr = wid >> 2, wc = wid & 3, fr = lane & 15, fq = lane >> 4;
    constexpr int nt = C::K / BK;
    unsigned voffA[2], voffB[2];
#pragma unroll
    for (int i = 0; i < 2; ++i) { int R, Cc; stage_rc(tid * 16 + i * 8192, R, Cc); const int Rb = (R & ~31) + perm32(R & 31);
        voffA[i] = (unsigned)(R * C::LDA + Cc) * 2u; voffB[i] = (unsigned)(Rb * C::LDB + Cc) * 2u; }
    constexpr size_t kstep = (size_t)(BK * 2);
    constexpr size_t hstepA = (size_t)HALF * C::LDA * 2, hstepB = (size_t)HALF * C::LDB * 2;
    const unsigned ldsw = (unsigned)wid * 1024u;
    const int aoff = lds_byte(wr * 64 + fr, fq * 8), boff = lds_byte(wc * 32 + fr, fq * 8);
#define PG8_SA(b, h) (((b) * 2 + (h)) * HTB)
#define PG8_SB(b, h) ((4 + (b) * 2 + (h)) * HTB)
#define PG8_STAGE(bufoff, gbase, voff) do { _Pragma("unroll") for (int _i = 0; _i < 2; ++_i) \
        __builtin_amdgcn_global_load_lds((const unsigned*)((const char*)(gbase) + (voff)[_i]), (LAS unsigned*)(lds + (bufoff) + ldsw + _i * 8192), 16, 0, 0); } while (0)
#define PG8_LDA(dst, b, h) do { _Pragma("unroll") for (int m = 0; m < 4; ++m) _Pragma("unroll") for (int k = 0; k < 2; ++k) dst[m][k] = *(const LAS bf16x8*)(lds + PG8_SA(b, h) + aoff + m * 2048 + k * 1024); } while (0)
#define PG8_LDB(dst, b, h) do { _Pragma("unroll") for (int n = 0; n < 2; ++n) _Pragma("unroll") for (int k = 0; k < 2; ++k) dst[n][k] = *(const LAS bf16x8*)(lds + PG8_SB(b, h) + boff + n * 2048 + k * 1024); } while (0)
#define PG8_MMA(ai, bj, At, Bt) do { __builtin_amdgcn_s_setprio(1); _Pragma("unroll") for (int m = 0; m < 4; ++m) _Pragma("unroll") for (int n = 0; n < 2; ++n) _Pragma("unroll") for (int k = 0; k < 2; ++k) \
        acc[ai][bj][m][n] = __builtin_amdgcn_mfma_f32_16x16x32_bf16(Bt[n][k], At[m][k], acc[ai][bj][m][n], 0, 0, 0); __builtin_amdgcn_s_setprio(0); } while (0)
#define PG8_WAIT_V(n) asm volatile("s_waitcnt vmcnt(" #n ")" ::: "memory")
#define PG8_WAIT_L(n) asm volatile("s_waitcnt lgkmcnt(" #n ")" ::: "memory")
#define PG8_BAR __builtin_amdgcn_s_barrier()
#define PG8_SCHED __builtin_amdgcn_sched_barrier(0)
    Unit cur, nxt; int ui = 0;
    if (!S.next(0, cur)) return;
    f32x4 acc[2][2][4][2];
#pragma unroll
    for (int a = 0; a < 2; ++a)
#pragma unroll
        for (int b = 0; b < 2; ++b)
#pragma unroll
            for (int m = 0; m < 4; ++m)
#pragma unroll
                for (int n = 0; n < 2; ++n) acc[a][b][m][n] = (f32x4){0.f, 0.f, 0.f, 0.f};
    bf16x8 At[4][2], B0[2][2], B1[2][2];
    const char* cA = unitA<C>(g, cur); const char* cB = unitB<C>(g, cur);
    PG8_STAGE(PG8_SB(0, 0), cB, voffB); PG8_STAGE(PG8_SB(0, 1), cB + hstepB, voffB); PG8_STAGE(PG8_SA(0, 0), cA, voffA); PG8_STAGE(PG8_SA(0, 1), cA + hstepA, voffA);
    if (wr == 1) PG8_BAR;
    PG8_WAIT_V(2); PG8_BAR;
    PG8_STAGE(PG8_SB(1, 0), cB + kstep, voffB); PG8_STAGE(PG8_SA(1, 0), cA + kstep, voffA); PG8_STAGE(PG8_SB(1, 1), cB + hstepB + kstep, voffB);
    PG8_WAIT_V(6); PG8_BAR;
    for (;;) {
        const bool has_next = S.next(ui + 1, nxt);
        const char* nA = has_next ? unitA<C>(g, nxt) : cA; const char* nB = has_next ? unitB<C>(g, nxt) : cB;
#define PG8_KBODY(U0, U1) { \
            const bool last = (t == nt - 2); \
            const char* a1 = cA + (size_t)(t + 1) * kstep; \
            const char* a2 = last ? nA : cA + (size_t)(t + 2) * kstep; const char* b2 = last ? nB : cB + (size_t)(t + 2) * kstep; \
            const char* a3 = a2 + kstep; const char* b3 = b2 + kstep; \
            if (U0) PG8_LDB(B0, 0, 0); if (U1) PG8_LDB(B1, 0, 1); PG8_SCHED; PG8_LDA(At, 0, 0); PG8_STAGE(PG8_SA(1, 1), a1 + hstepA, voffA); \
            PG8_WAIT_V(8); PG8_WAIT_L(0); PG8_BAR; if (U0) PG8_MMA(0, 0, At, B0); if (U1) PG8_MMA(0, 1, At, B1); PG8_BAR; PG8_SCHED; \
            PG8_LDA(At, 0, 1); PG8_STAGE(PG8_SB(0, 0), b2, voffB); PG8_STAGE(PG8_SB(0, 1), b2 + hstepB, voffB); PG8_STAGE(PG8_SA(0, 0), a2, voffA); \
            PG8_WAIT_V(8); PG8_WAIT_L(0); PG8_BAR; if (U0) PG8_MMA(1, 0, At, B0); if (U1) PG8_MMA(1, 1, At, B1); PG8_BAR; PG8_SCHED; \
            if (U0) PG8_LDB(B0, 1, 0); if (U1) PG8_LDB(B1, 1, 1); PG8_SCHED; PG8_LDA(At, 1, 0); PG8_STAGE(PG8_SA(0, 1), a2 + hstepA, voffA); \
            PG8_WAIT_V(8); PG8_WAIT_L(0); PG8_BAR; if (U0) PG8_MMA(0, 0, At, B0); if (U1) PG8_MMA(0, 1, At, B1); PG8_BAR; PG8_SCHED; \
            PG8_LDA(At, 1, 1); PG8_STAGE(PG8_SB(1, 0), b3, voffB); PG8_STAGE(PG8_SB(1, 1), b3 + hstepB, voffB); PG8_STAGE(PG8_SA(1, 0), a3, voffA); \
            PG8_WAIT_V(8); PG8_WAIT_L(0); PG8_BAR; if (U0) PG8_MMA(1, 0, At, B0); if (U1) PG8_MMA(1, 1, At, B1); PG8_BAR; PG8_SCHED; }
        if constexpr (C::HK) {
#pragma unroll 1
            for (int t = 0; t < nt / 2; t += 2) PG8_KBODY(true, false)
#pragma unroll 1
            for (int t = nt / 2; t < nt; t += 2) PG8_KBODY(false, true)
        } else {
#pragma unroll 1
            for (int t = 0; t < nt; t += 2) PG8_KBODY(true, true)
        }
#undef PG8_KBODY
        if (wr == 0) PG8_BAR;
        E(acc, cur, wr, wc, fr, fq);
        if (!has_next) break;
#pragma unroll
        for (int a = 0; a < 2; ++a)
#pragma unroll
            for (int b = 0; b < 2; ++b)
#pragma unroll
                for (int m = 0; m < 4; ++m)
#pragma unroll
                    for (int n = 0; n < 2; ++n) acc[a][b][m][n] = (f32x4){0.f, 0.f, 0.f, 0.f};
        cur = nxt; cA = nA; cB = nB; ++ui;
        if (wr == 1) PG8_BAR;
    }
    PG8_WAIT_V(0);
    PG8_BAR;
#undef PG8_SA
#undef PG8_SB
#undef PG8_STAGE
#undef PG8_LDA
#undef PG8_LDB
#undef PG8_MMA
#undef PG8_WAIT_V
#undef PG8_WAIT_L
#undef PG8_BAR
#undef PG8_SCHED
}
}
using pg8::Unit;

#define EPI_LOOP_BEGIN \
    _Pragma("unroll") for (int ai = 0; ai < 2; ++ai) _Pragma("unroll") for (int m = 0; m < 4; ++m) { const int r = u.pm * 256 + ai * 128 + wr * 64 + m * 16 + fr;
#define EPI_LOOP_END asm volatile("" ::: "memory"); }

struct EpiInproj {
    unsigned char* ws;
    DI void operator()(const f32x4 (&acc)[2][2][4][2], const Unit& u, int wr, int wc, int fr, int fq) const {
        const int pn = u.pn; const int mode = (pn >= 15) ? 2 : ((pn == 4 || pn == 8 || pn == 12 || pn == 14) ? 1 : 0);
        if (pn == 31) {
            if (wc == 0 && fq < 2) {
#pragma unroll
                for (int ai = 0; ai < 2; ++ai)
#pragma unroll
                    for (int m = 0; m < 4; ++m) { const int r = u.pm * 256 + ai * 128 + wr * 64 + m * 16 + fr; const float rs = ((const float*)(ws + WS_RSTD))[r]; float* gp = (float*)(ws + WS_G12) + (size_t)r * 12 + 8 * fq;
#pragma unroll
                        for (int e = 0; e < 4; ++e) { gp[e] = sigm(acc[ai][0][m][0][e] * rs); if (fq == 0) gp[4 + e] = sigm(acc[ai][0][m][1][e] * rs); } } }
            return; }
        float rsv[8];
#pragma unroll
        for (int it = 0; it < 8; ++it) rsv[it] = ((const float*)(ws + WS_RSTD))[u.pm * 256 + (it >> 2) * 128 + wr * 64 + (it & 3) * 16 + fr];
#pragma unroll
        for (int ai = 0; ai < 2; ++ai)
#pragma unroll
            for (int m = 0; m < 4; ++m) { const int r = u.pm * 256 + ai * 128 + wr * 64 + m * 16 + fr; const float rs = rsv[ai * 4 + m];
#pragma unroll
            for (int bj = 0; bj < 2; ++bj) { const int c8 = pn * 256 + bj * 128 + wc * 32 + 8 * fq;
                float v[8];
#pragma unroll
                for (int e = 0; e < 4; ++e) { v[e] = acc[ai][bj][m][0][e] * rs; v[4 + e] = acc[ai][bj][m][1][e] * rs; }
                if (mode == 1) {
#pragma unroll
                    for (int e = 0; e < 8; ++e) v[e] = v[e] * sigm(v[e]); }
                if (pn < 15) { u32x4 w; w.x = cvtpk(v[0], v[1]); w.y = cvtpk(v[2], v[3]); w.z = cvtpk(v[4], v[5]); w.w = cvtpk(v[6], v[7]);
                    *(u32x4*)((bf16_t*)(ws + WS_PROJ) + (size_t)r * NP + c8) = w; }
                else { unsigned q0 = 0u, q1 = 0u;
#pragma unroll
                    for (int e = 0; e < 4; ++e) { q0 = __builtin_amdgcn_cvt_pk_u8_f32(sigm(v[e]) * 255.f, e, q0); q1 = __builtin_amdgcn_cvt_pk_u8_f32(sigm(v[4 + e]) * 255.f, e, q1); }
                    *(u32x2*)((unsigned char*)(ws + WS_GATES) + (size_t)r * NGATE + (c8 - NP)) = (u32x2){q0, q1}; } } }
    }
};
struct EpiGlu {
    unsigned char* ws; const float* glub;
    DI void operator()(const f32x4 (&acc)[2][2][4][2], const Unit& u, int wr, int wc, int fr, int fq) const {
        const int col = u.pn * 128 + wc * 32 + 8 * fq;
        EPI_LOOP_BEGIN
            float z[8]; unpack8(*(const u32x4*)((const bf16_t*)(ws + WS_PROJ) + (size_t)r * NP + C_S5Z + col), z);
            float ba[8], bg[8];
#pragma unroll
            for (int e = 0; e < 8; ++e) { ba[e] = glub[col + e]; bg[e] = glub[256 + col + e]; }
            float v[8];
#pragma unroll
            for (int e = 0; e < 8; ++e) { const float a = acc[ai][0][m][e >> 2][e & 3] + ba[e], gg = acc[ai][1][m][e >> 2][e & 3] + bg[e]; v[e] = a * sigm(gg) * z[e]; }
            u32x4 w; w.x = cvtpk(v[0], v[1]); w.y = cvtpk(v[2], v[3]); w.z = cvtpk(v[4], v[5]); w.w = cvtpk(v[6], v[7]);
            *(u32x4*)((bf16_t*)(ws + WS_OUTS) + (size_t)r * DM + 768 + col) = w;
        EPI_LOOP_END
    }
};
DI void unpack_u8(u32x2 w, float (&f)[8]) {
    f[0] = (float)(w.x & 0xffu); f[1] = (float)((w.x >> 8) & 0xffu); f[2] = (float)((w.x >> 16) & 0xffu); f[3] = (float)(w.x >> 24);
    f[4] = (float)(w.y & 0xffu); f[5] = (float)((w.y >> 8) & 0xffu); f[6] = (float)((w.y >> 16) & 0xffu); f[7] = (float)(w.y >> 24);
}
struct EpiBranch {
    unsigned char* ws;
    DI void operator()(const f32x4 (&acc)[2][2][4][2], const Unit& u, int wr, int wc, int fr, int fq) const {
        const int z = u.z; const int cb = u.pn * 128 + wc * 32 + 8 * fq;
        const unsigned char* gbase = (const unsigned char*)(ws + WS_GATES) + (2 * z) * 1024 + cb; bf16_t* tbase = (bf16_t*)(ws + WS_TMP) + cb;
        u32x2 g0 = {0, 0}, g1 = g0, ng0 = g0, ng1 = g0; u32x4 t0 = {0, 0, 0, 0}, nt0 = t0;
        { const size_t r = (size_t)(u.pm * 256 + wr * 64 + fr); g0 = *(const u32x2*)(gbase + r * NGATE); g1 = *(const u32x2*)(gbase + r * NGATE + 1024);
          if (z > 0) t0 = *(const u32x4*)(tbase + r * DM); }
#pragma unroll
        for (int it = 0; it < 8; ++it) { const int ai = it >> 2, m = it & 3; const size_t r = (size_t)(u.pm * 256 + ai * 128 + wr * 64 + m * 16 + fr);
            if (it < 7) { const size_t rn = (size_t)(u.pm * 256 + ((it + 1) >> 2) * 128 + wr * 64 + ((it + 1) & 3) * 16 + fr);
                ng0 = *(const u32x2*)(gbase + rn * NGATE); ng1 = *(const u32x2*)(gbase + rn * NGATE + 1024);
                if (z > 0) nt0 = *(const u32x4*)(tbase + rn * DM); }
            asm volatile("" ::: "memory");
            { float ga[8], gb[8], t8[8], v[8]; unpack_u8(g0, ga); unpack_u8(g1, gb); unpack8(t0, t8);
#pragma unroll
              for (int e = 0; e < 8; ++e) { v[e] = (acc[ai][0][m][e >> 2][e & 3] * ga[e] + acc[ai][1][m][e >> 2][e & 3] * gb[e]) * (1.f / 255.f); if (z > 0) v[e] += t8[e]; }
              u32x4 w; w.x = cvtpk(v[0], v[1]); w.y = cvtpk(v[2], v[3]); w.z = cvtpk(v[4], v[5]); w.w = cvtpk(v[6], v[7]);
              if (z == 0) *(u32x4*)(tbase + r * DM) = w; else *(u32x4*)((bf16_t*)(ws + WS_MIXED) + r * DM + cb) = w; }
            g0 = ng0; g1 = ng1; t0 = nt0;
            asm volatile("" ::: "memory"); }
    }
};
struct EpiOut {
    const float* xin; float* xout;
    DI void operator()(const f32x4 (&acc)[2][2][4][2], const Unit& u, int wr, int wc, int fr, int fq) const {
        const int cb = u.pn * 256 + wc * 32 + 8 * fq;
        f32x4 x[4], nx[4];
        { const size_t off = (size_t)(u.pm * 256 + wr * 64 + fr) * DM + cb; x[0] = *(const f32x4*)(xin + off); x[1] = *(const f32x4*)(xin + off + 4); x[2] = *(const f32x4*)(xin + off + 128); x[3] = *(const f32x4*)(xin + off + 132); }
#pragma unroll
        for (int it = 0; it < 8; ++it) { const int ai = it >> 2, m = it & 3; const size_t off = (size_t)(u.pm * 256 + ai * 128 + wr * 64 + m * 16 + fr) * DM + cb;
            if (it < 7) { const size_t on = (size_t)(u.pm * 256 + ((it + 1) >> 2) * 128 + wr * 64 + ((it + 1) & 3) * 16 + fr) * DM + cb;
                nx[0] = *(const f32x4*)(xin + on); nx[1] = *(const f32x4*)(xin + on + 4); nx[2] = *(const f32x4*)(xin + on + 128); nx[3] = *(const f32x4*)(xin + on + 132); }
            asm volatile("" ::: "memory");
            *(f32x4*)(xout + off) = x[0] + acc[ai][0][m][0]; *(f32x4*)(xout + off + 4) = x[1] + acc[ai][0][m][1];
            *(f32x4*)(xout + off + 128) = x[2] + acc[ai][1][m][0]; *(f32x4*)(xout + off + 132) = x[3] + acc[ai][1][m][1];
#pragma unroll
            for (int q = 0; q < 4; ++q) x[q] = nx[q];
            asm volatile("" ::: "memory"); }
    }
};
struct EpiS5a {
    unsigned char* ws;
    DI void operator()(const f32x4 (&acc)[2][2][4][2], const Unit& u, int wr, int wc, int fr, int fq) const {
        EPI_LOOP_BEGIN
            const int c8 = wc * 32 + 8 * fq;
            float* p = (float*)(ws + WS_STL) + ((size_t)u.z * 256 + r) * 128 + c8;
            *(f32x4*)p = acc[ai][0][m][0]; *(f32x4*)(p + 4) = acc[ai][0][m][1];
        EPI_LOOP_END
    }
};
struct EpiS5b {
    unsigned char* ws;
    DI void operator()(const f32x4 (&acc)[2][2][4][2], const Unit& u, int wr, int wc, int fr, int fq) const {
        EPI_LOOP_BEGIN
            const int b = r >> 6, ch = r & 63;
#pragma unroll
            for (int bj = 0; bj < 2; ++bj) { const int col = u.pn * 256 + bj * 128 + wc * 32 + 8 * fq; const int t = col >> 4, c = col & 15;
                const size_t tok = (size_t)b * S + ch * 64 + t;
                u32x4 w; w.x = cvtpk(acc[ai][bj][m][0][0], acc[ai][bj][m][0][1]); w.y = cvtpk(acc[ai][bj][m][0][2], acc[ai][bj][m][0][3]);
                w.z = cvtpk(acc[ai][bj][m][1][0], acc[ai][bj][m][1][1]); w.w = cvtpk(acc[ai][bj][m][1][2], acc[ai][bj][m][1][3]);
                *(u32x4*)((bf16_t*)(ws + WS_Y5) + tok * 256 + u.z * 16 + c) = w; }
        EPI_LOOP_END
    }
};


#define XB_TMO      128
#define XB_XCNT(j)  (256  + 64 * (j))
#define XB_XSUB(j)  (1280 + 64 * (j))
#define XB_XGEN(j)  (2304 + 64 * (j))
#define XB_TOP      3328
#define XB_TOPGEN   3392
#define XCD_BAR_WORDS 3456
#define XB_SPIN_CAP (1u << 20)
DI unsigned xb_ld(unsigned* p)              { return __hip_atomic_load(p, __ATOMIC_RELAXED, __HIP_MEMORY_SCOPE_AGENT); }
DI unsigned xb_add(unsigned* p, unsigned v) { return __hip_atomic_fetch_add(p, v, __ATOMIC_RELAXED, __HIP_MEMORY_SCOPE_AGENT); }
DI unsigned xb_xcc_id() { return (unsigned)__builtin_amdgcn_s_getreg((3 << 11) | 20) & 0xFu; }
#define XB_SPIN(cond, bar) do { unsigned _sp = 0; while (cond) { __builtin_amdgcn_s_sleep(1); \
    if ((++_sp & 255u) == 0u) { if (xb_ld(&(bar)[XB_TMO])) break; if (_sp > XB_SPIN_CAP) { atomicAdd(&(bar)[XB_TMO], 1u); break; } } } } while (0)
struct XcdBarrier { unsigned* bar; unsigned x; volatile LAS unsigned* st; };
DI XcdBarrier xcd_barrier_post(unsigned* bar, volatile LAS unsigned* st) {
    XcdBarrier b; b.bar = bar; b.x = xb_xcc_id(); b.st = st;
    if (threadIdx.x == 0) (void)xb_add(&bar[XB_XCNT(b.x)], 1u);
    return b;
}
DI void xcd_barrier_complete(unsigned* bar, unsigned x, unsigned& nloc, unsigned& nx) {
    const unsigned G = gridDim.x * gridDim.y * gridDim.z;
    unsigned sum, cnt, mine, sp = 0u;
    for (;;) {
        sum = 0u; cnt = 0u; mine = 0u;
#pragma unroll
        for (unsigned j = 0; j < 16; ++j) { const unsigned c = xb_ld(&bar[XB_XCNT(j)]); sum += c; cnt += (c > 0u) ? 1u : 0u; mine = (j == x) ? c : mine; }
        if (sum == G) break;
        __builtin_amdgcn_s_sleep(1);
        if ((++sp & 255u) == 0u) { if (xb_ld(&bar[XB_TMO])) break; if (sp > XB_SPIN_CAP) { atomicAdd(&bar[XB_TMO], 1u); break; } }
    }
    nloc = mine > 0u ? mine : 1u; nx = cnt > 0u ? cnt : 1u;
}
DI void xcd_barrier(const XcdBarrier& b) {
    asm volatile("s_waitcnt vmcnt(0)" ::: "memory");
    __syncthreads();
    if (threadIdx.x == 0) {
        unsigned* bar = b.bar;
        __builtin_amdgcn_s_waitcnt(0);
        unsigned nloc = b.st[0], nx = b.st[1];
        if (nloc == 0u) { xcd_barrier_complete(bar, b.x, nloc, nx); b.st[0] = nloc; b.st[1] = nx; }
        const unsigned old = xb_add(&bar[XB_XSUB(b.x)], 1u);
        const unsigned gen = old / nloc;
        if (old + 1u == (gen + 1u) * nloc) {
            __builtin_amdgcn_fence(__ATOMIC_RELEASE, "agent");
            asm volatile("s_waitcnt vmcnt(0)" ::: "memory");
            const unsigned og = xb_add(&bar[XB_TOP], 1u);
            const unsigned tg = og / nx;
            if (og + 1u == (tg + 1u) * nx) xb_add(&bar[XB_TOPGEN], 1u);
            else XB_SPIN(xb_ld(&bar[XB_TOPGEN]) == tg, bar);
            __builtin_amdgcn_fence(__ATOMIC_ACQUIRE, "agent");
            xb_add(&bar[XB_XGEN(b.x)], 1u);
            asm volatile("s_waitcnt vmcnt(0)" ::: "memory");
        } else {
            XB_SPIN(xb_ld(&bar[XB_XGEN(b.x)]) == gen, bar);
            __builtin_amdgcn_fence(__ATOMIC_ACQUIRE, "agent");
            asm volatile("s_waitcnt vmcnt(0)" ::: "memory");
        }
    }
    __syncthreads();
}

DI void cnt_barrier(unsigned* ctr, unsigned target) {
    asm volatile("s_waitcnt vmcnt(0)" ::: "memory");
    __syncthreads();
    if (threadIdx.x == 0) {
        __builtin_amdgcn_fence(__ATOMIC_RELEASE, "agent"); asm volatile("s_waitcnt vmcnt(0)" ::: "memory");
        __hip_atomic_fetch_add(ctr, 1u, __ATOMIC_RELAXED, __HIP_MEMORY_SCOPE_AGENT);
        unsigned sp = 0;
        while (__hip_atomic_load(ctr, __ATOMIC_RELAXED, __HIP_MEMORY_SCOPE_AGENT) < target) { __builtin_amdgcn_s_sleep(1); if (++sp > (1u << 24)) break; }
        __builtin_amdgcn_fence(__ATOMIC_ACQUIRE, "agent"); asm volatile("s_waitcnt vmcnt(0)" ::: "memory");
    }
    __syncthreads();
}
constexpr int CW_BAR = 16384, CW_FLAG = 32768;
constexpr int MISC_OFF = 131072 + 320;
struct Args { const float* in[21]; float* out; unsigned char* ws; };
struct Ctx {
    LAS unsigned char* lds; int tid, lane, wave, G, gw, NGW; long gtid, GT;
    unsigned char* ws;
};

DI Ctx mkctx(unsigned char* ws, LAS unsigned char* lds) {
    Ctx F; int tid = threadIdx.x; asm volatile("" : "+v"(tid));
    F.lds = lds; F.tid = tid; F.lane = tid & 63; F.wave = __builtin_amdgcn_readfirstlane(tid >> 6);
    F.G = gridDim.x; F.gw = blockIdx.x * NWAVES + F.wave; F.NGW = F.G * NWAVES; F.gtid = (long)blockIdx.x * NTHR + tid; F.GT = (long)F.G * NTHR; F.ws = ws; return F;
}
DI void transpose_item(const float* W, int ldw, int srccol0, const float* kscale, bf16_t* WT, int ldwt, int dstrow0, int k0, LAS float* scr, int lane, int nvalid = 32) {
#pragma unroll 8
    for (int i = 0; i < 32; ++i) { const int kk = 2 * i + (lane >> 5); float v = (lane & 31) < nvalid ? W[(size_t)(k0 + kk) * ldw + srccol0 + (lane & 31)] : 0.f; if (kscale) v *= kscale[k0 + kk]; scr[kk * 33 + (lane & 31)] = v; }
    LDS_WAIT();
    const int c = lane & 7;
#pragma unroll
    for (int j = 0; j < 4; ++j) { const int n = (lane >> 3) + 8 * j; const LAS float* s = scr + (8 * c) * 33 + n;
        u32x4 o; o.x = cvtpk(s[0 * 33], s[1 * 33]); o.y = cvtpk(s[2 * 33], s[3 * 33]); o.z = cvtpk(s[4 * 33], s[5 * 33]); o.w = cvtpk(s[6 * 33], s[7 * 33]);
        *(u32x4*)(WT + (size_t)(dstrow0 + n) * ldwt + k0 + 8 * c) = o; }
    LDS_WAIT();
}
DI void k1_prologue(const Ctx& F, const Args& a) {
    LAS float* scr = (LAS float*)(F.lds + F.wave * 16384);
    unsigned char* ws = F.ws;
    constexpr int I_WIN = 16 * 256, I_WB = 128, I_WOUT = 512, I_GLU = 64, I_CW1 = 64;
    constexpr int N_WIN = 2 * I_WIN, N_WB = 8 * I_WB, N_WOUT = 2 * I_WOUT, N_GLU = 2 * I_GLU, N_CW1 = 4 * I_CW1;
    for (int it = F.gw; it < N_WIN + N_WB + N_WOUT + N_GLU + N_CW1; it += F.NGW) {
        int r = it;
        if (r < N_WIN) { const int l = r / I_WIN; r %= I_WIN; const int kb = r / 256, nb = r % 256, n0 = nb * 32;
            const int src = n0 < 1024 ? n0 : (n0 < NIN ? n0 + 12 : 1024), nv = n0 < NIN ? 32 : (n0 == NIN ? 12 : 0);
            transpose_item(a.in[3] + (size_t)l * DM * NINW, NINW, src, a.in[2] + l * DM, (bf16_t*)(ws + WS_WINT) + (size_t)l * NINP * DM, DM, n0, kb * 64, scr, F.lane, nv); continue; }
        r -= N_WIN;
        if (r < N_WB) { const int lm = r / I_WB; r %= I_WB; const int kb = r / 32, nb = r % 32, m = lm & 3, l = lm >> 2;
            transpose_item(a.in[19] + (size_t)lm * 256 * DM, DM, nb * 32, nullptr, (bf16_t*)(ws + WS_WB2T) + ((size_t)(l * 2 + (m >> 1)) * 8 + (nb >> 2)) * (256 * 512) + (m & 1) * 256, 512, (m & 1) * 128 + (nb & 3) * 32, kb * 64, scr, F.lane); continue; }
        r -= N_WB;
        if (r < N_WOUT) { const int l = r / I_WOUT; r %= I_WOUT; const int kb = r / 32, nb = r % 32;
            transpose_item(a.in[20] + (size_t)l * DM * DM, DM, nb * 32, nullptr, (bf16_t*)(ws + WS_WOUTT) + (size_t)l * DM * DM, DM, nb * 32, kb * 64, scr, F.lane); continue; }
        r -= N_WOUT;
        if (r < N_GLU) { const int l = r / I_GLU; r %= I_GLU; const int kb = r / 16, nb = r % 16, n0 = nb * 32; const int pn = n0 >> 8, bj = (n0 >> 7) & 1, lc = n0 & 127;
            transpose_item(a.in[17] + (size_t)l * 256 * 512, 512, bj * 256 + pn * 128 + lc, nullptr, (bf16_t*)(ws + WS_GLUT) + (size_t)l * 512 * 256, 256, n0, kb * 64, scr, F.lane); continue; }
        r -= N_GLU;
        { const int lj = r / I_CW1; r %= I_CW1; const int kb = r / 2, nb = r % 2;
            transpose_item(a.in[6] + (size_t)lj * 2048 * 64, 64, nb * 32, nullptr, (bf16_t*)(ws + WS_CW1T) + (size_t)lj * 64 * 2048, 2048, nb * 32, kb * 64, scr, F.lane); }
    }
    for (long i = F.gtid; i < 2 * 2 * 8 * 256 * 32; i += F.GT) { const int q16 = (int)(i & 31), row = (int)((i >> 5) & 255); const long blk = i >> 13;
        *(u32x4*)((bf16_t*)(ws + WS_WB2T) + (size_t)blk * (256 * 512) + (size_t)row * 512 + (row < 128 ? 256 : 0) + q16 * 8) = (u32x4){0u, 0u, 0u, 0u}; }
    float* bias1 = (float*)(ws + WS_CTL + 32768);
    for (long i = F.gtid; i < 4 * 64 * 16; i += F.GT) { const int o = (int)(i & 63), kc = (int)((i >> 6) & 15), lj = (int)(i >> 10); float s = 0.f;
        for (int k = kc * 128; k < kc * 128 + 128; ++k) s += a.in[5][lj * 2048 + k] * a.in[6][((size_t)lj * 2048 + k) * 64 + o];
        bias1[(lj * 16 + kc) * 64 + o] = s; }
    f32x2* pw = (f32x2*)(ws + WS_POW);
    for (long i = F.gtid; i < 2 * 16 * 64 * 65; i += F.GT) { const int k = (int)(i % 65), p = (int)((i / 65) % 64), lg = (int)(i / (65 * 64));
        const float dt = __expf(a.in[11][lg]), lr = a.in[9][lg * 64 + p], li = a.in[10][lg * 64 + p];
        const float mag = __expf(lr * dt * (float)k); float sn, cs; sincos_acc(li * dt * (float)k, sn, cs); pw[i] = (f32x2){mag * cs, mag * sn}; }
    f32x2* bb = (f32x2*)(ws + WS_BBAR);
    for (long i = F.gtid; i < 2 * 16 * 64 * 16; i += F.GT) { const int c = (int)(i & 15), p = (int)((i >> 4) & 63), lg = (int)(i >> 10);
        const float dt = __expf(a.in[11][lg]), lr = a.in[9][lg * 64 + p], li = a.in[10][lg * 64 + p];
        const float mag = __expf(lr * dt); float sn, cs; sincos_acc(li * dt, sn, cs); const float abr = mag * cs, abi = mag * sn, den = lr * lr + li * li;
        const float cr = ((abr - 1.f) * lr + abi * li) / den, ci = (abi * lr - (abr - 1.f) * li) / den;
        const float br = a.in[12][((size_t)lg * 64 + p) * 16 + c], bi = a.in[13][((size_t)lg * 64 + p) * 16 + c];
        bb[i] = (f32x2){cr * br - ci * bi, cr * bi + ci * br}; }
}
DI void kmat_build(const Ctx& F, const Args& a) {
    const f32x2* pw = (const f32x2*)(F.ws + WS_POW); const f32x2* bb = (const f32x2*)(F.ws + WS_BBAR); float* km = (float*)(F.ws + WS_KMAT);
    for (long i = F.gtid; i < 2 * 16 * 64 * 256; i += F.GT) { const int cc = (int)(i & 15), c = (int)((i >> 4) & 15), k = (int)((i >> 8) & 63), lg = (int)(i >> 14); float s = 0.f;
        for (int p = 0; p < 64; ++p) { const float cr = a.in[14][((size_t)lg * 16 + c) * 64 + p], ci = a.in[15][((size_t)lg * 16 + c) * 64 + p];
            const f32x2 w = pw[((size_t)lg * 64 + p) * 65 + k], b = bb[((size_t)lg * 64 + p) * 16 + cc];
            const float xr = cr * w.x - ci * w.y, xi = cr * w.y + ci * w.x; s += xr * b.x - xi * b.y; }
        if (k == 0 && c == cc) s += a.in[16][lg * 16 + c];
        km[i] = s; }
}
DI void s5_expand(const Ctx& F, const Args& a, int l) {
    const f32x2* pw = (const f32x2*)(F.ws + WS_POW); const f32x2* bb = (const f32x2*)(F.ws + WS_BBAR); const float* km = (const float*)(F.ws + WS_KMAT);
    bf16_t* spg = (bf16_t*)(F.ws + WS_SPG); bf16_t* sa2 = (bf16_t*)(F.ws + WS_SA2);
    for (long i = F.gtid; i < 16 * 256 * 64; i += F.GT) { const int tt = (int)(i & 63), comp = (int)((i >> 6) & 255), g = (int)(i >> 14), lg = l * 16 + g;
        float v[16];
        if (comp < 128) { const int p = comp & 63; const f32x2 w = pw[((size_t)lg * 64 + p) * 65 + 63 - tt];
#pragma unroll
            for (int c = 0; c < 16; ++c) { const f32x2 b = bb[((size_t)lg * 64 + p) * 16 + c]; v[c] = comp < 64 ? (w.x * b.x - w.y * b.y) : (w.x * b.y + w.y * b.x); } }
        else {
#pragma unroll
            for (int c = 0; c < 16; ++c) v[c] = 0.f; }
        u32x4 o0, o1; o0.x = cvtpk(v[0], v[1]); o0.y = cvtpk(v[2], v[3]); o0.z = cvtpk(v[4], v[5]); o0.w = cvtpk(v[6], v[7]);
        o1.x = cvtpk(v[8], v[9]); o1.y = cvtpk(v[10], v[11]); o1.z = cvtpk(v[12], v[13]); o1.w = cvtpk(v[14], v[15]);
        bf16_t* d = spg + ((size_t)g * 256 + comp) * 1024 + tt * 16; *(u32x4*)d = o0; *(u32x4*)(d + 8) = o1; }
    for (long i = F.gtid; i < 16 * 64 * 16 * 64; i += F.GT) { const int tt = (int)(i & 63), c = (int)((i >> 6) & 15), t = (int)((i >> 10) & 63), g = (int)(i >> 16), lg = l * 16 + g;
        float v[16];
        if (t >= tt) { const float* s = km + (((size_t)lg * 64 + (t - tt)) * 16 + c) * 16;
#pragma unroll
            for (int e = 0; e < 16; ++e) v[e] = s[e]; }
        else {
#pragma unroll
            for (int e = 0; e < 16; ++e) v[e] = 0.f; }
        u32x4 o0, o1; o0.x = cvtpk(v[0], v[1]); o0.y = cvtpk(v[2], v[3]); o0.z = cvtpk(v[4], v[5]); o0.w = cvtpk(v[6], v[7]);
        o1.x = cvtpk(v[8], v[9]); o1.y = cvtpk(v[10], v[11]); o1.z = cvtpk(v[12], v[13]); o1.w = cvtpk(v[14], v[15]);
        bf16_t* d = sa2 + ((size_t)g * 1024 + t * 16 + c) * 1152 + tt * 16; *(u32x4*)d = o0; *(u32x4*)(d + 8) = o1; }
    for (long i = F.gtid; i < 16 * 64 * 16 * 16; i += F.GT) { const int c8 = (int)(i & 15), c = (int)((i >> 4) & 15), t = (int)((i >> 8) & 63), g = (int)(i >> 14), lg = l * 16 + g;
        float v[8];
#pragma unroll
        for (int e = 0; e < 8; ++e) { const int comp = c8 * 8 + e, p = comp & 63; const f32x2 w = pw[((size_t)lg * 64 + p) * 65 + t + 1];
            const float cr = a.in[14][((size_t)lg * 16 + c) * 64 + p], ci = a.in[15][((size_t)lg * 16 + c) * 64 + p];
            v[e] = comp < 64 ? (cr * w.x - ci * w.y) : -(cr * w.y + ci * w.x); }
        u32x4 o; o.x = cvtpk(v[0], v[1]); o.y = cvtpk(v[2], v[3]); o.z = cvtpk(v[4], v[5]); o.w = cvtpk(v[6], v[7]);
        *(u32x4*)(sa2 + ((size_t)g * 1024 + t * 16 + c) * 1152 + 1024 + c8 * 8) = o; }
}

DI void p1_pre(const Ctx& F, const float* xin, int l) {
    bf16_t* xb = (bf16_t*)(F.ws + WS_XB); float* rstd = (float*)(F.ws + WS_RSTD);
    for (int tok0 = F.gw; tok0 < TH; tok0 += 2 * F.NGW) {
        const int tok1 = tok0 + F.NGW < TH ? tok0 + F.NGW : tok0;
        const f32x4* xr0 = (const f32x4*)(xin + (size_t)tok0 * DM) + F.lane; const f32x4* xr1 = (const f32x4*)(xin + (size_t)tok1 * DM) + F.lane;
        f32x4 v0[4], v1[4]; float s0 = 0.f, s1 = 0.f;
#pragma unroll
        for (int j = 0; j < 4; ++j) { v0[j] = xr0[64 * j]; v1[j] = xr1[64 * j]; }
#pragma unroll
        for (int j = 0; j < 4; ++j) { s0 += (v0[j].x * v0[j].x + v0[j].y * v0[j].y) + (v0[j].z * v0[j].z + v0[j].w * v0[j].w); s1 += (v1[j].x * v1[j].x + v1[j].y * v1[j].y) + (v1[j].z * v1[j].z + v1[j].w * v1[j].w); }
        const float r0 = __builtin_amdgcn_rsqf(wave_sum(s0) * (1.f / DM) + EPS), r1 = __builtin_amdgcn_rsqf(wave_sum(s1) * (1.f / DM) + EPS);
        u32x2* o0 = (u32x2*)(xb + (size_t)tok0 * DM) + F.lane; u32x2* o1 = (u32x2*)(xb + (size_t)tok1 * DM) + F.lane;
#pragma unroll
        for (int j = 0; j < 4; ++j) { o0[64 * j] = (u32x2){cvtpk(v0[j].x, v0[j].y), cvtpk(v0[j].z, v0[j].w)}; o1[64 * j] = (u32x2){cvtpk(v1[j].x, v1[j].y), cvtpk(v1[j].z, v1[j].w)}; }
        if (F.lane == 0) { rstd[tok0] = r0; rstd[tok1] = r1; }
    }
}

#define DPPF(v, ctrl) __builtin_bit_cast(float, __builtin_amdgcn_update_dpp(0, __builtin_bit_cast(int, (v)), (ctrl), 0xF, 0xF, true))
DI void p3_qk(const Ctx& F, const Args& a, int l, int half) {
    const bf16_t* proj = (const bf16_t*)(F.ws + WS_PROJ); bf16_t* qn = (bf16_t*)(F.ws + WS_QN); bf16_t* ks = (bf16_t*)(F.ws + WS_KS); bf16_t* kw = (bf16_t*)(F.ws + WS_KW);
    const int* pos = (const int*)a.in[1]; const float* qkg = a.in[4] + l * 256; const int lane = F.lane, sub = lane >> 4, d0 = (lane & 15) * 4;
    float invf[4], g0[4], g2[4], g3[4];
#pragma unroll
    for (int e = 0; e < 4; ++e) { invf[e] = ex2(-(float)((d0 + e) & 31) * (13.287712379549449f / 32.f)); g0[e] = qkg[d0 + e]; g2[e] = qkg[128 + d0 + e]; g3[e] = qkg[192 + d0 + e]; }
    for (int t4 = F.gw; t4 < TH / 4; t4 += F.NGW) { const int tok = t4 * 4 + sub, b = tok >> 12, s = tok & 4095;
        const bf16_t* pr = proj + (size_t)tok * NP + d0;
        u32x2 raw[8];
#pragma unroll
        for (int vv = 0; vv < 8; ++vv) { const int col = vv < 4 ? C_NQ + vv * 64 : (vv < 6 ? C_NKV + 256 + (vv - 4) * 64 : C_NKV + 512 + (vv - 6) * 64); raw[vv] = *(const u32x2*)(pr + col); }
        const float pf = (float)pos[(half * NBH + b) * S + s]; float sn[4], cs[4];
#pragma unroll
        for (int e = 0; e < 4; ++e) sincos_acc(pf * invf[e], sn[e], cs[e]);
        const size_t fo = (size_t)(s >> 6) * 4096 + ((((s >> 5) & 1) * 4 + (d0 >> 4)) * 64 + ((d0 >> 3) & 1) * 32 + (s & 31)) * 8 + (d0 & 7);
#pragma unroll
        for (int vv = 0; vv < 8; ++vv) { float x[4]; unpack4(raw[vv], x);
            float ss = (x[0] * x[0] + x[1] * x[1]) + (x[2] * x[2] + x[3] * x[3]);
            ss += DPPF(ss, 0xB1); ss += DPPF(ss, 0x4E); ss += DPPF(ss, 0x124); ss += DPPF(ss, 0x128);
            const float rs = __builtin_amdgcn_rsqf(ss * (1.f / 64.f) + EPS); float r[4];
#pragma unroll
            for (int e = 0; e < 4; ++e) { const float y = x[e] * rs * (vv < 4 ? g0[e] : (vv < 6 ? g2[e] : g3[e])); const float o = DPPF(y, 0x128);
                r[e] = d0 < 32 ? y * cs[e] - o * sn[e] : y * cs[e] + o * sn[e]; }
            if (vv < 4) *(u32x2*)(qn + (size_t)tok * 256 + vv * 64 + d0) = (u32x2){cvtpk(r[0] * (0.125f * LOG2E), r[1] * (0.125f * LOG2E)), cvtpk(r[2] * (0.125f * LOG2E), r[3] * (0.125f * LOG2E))};
            else { bf16_t* kd = (vv < 6 ? ks + ((size_t)b * 2 + (vv - 4)) * S * 64 : kw + ((size_t)b * 2 + (vv - 6)) * S * 64) + fo; *(u32x2*)kd = (u32x2){cvtpk(r[0], r[1]), cvtpk(r[2], r[3])}; }
        }
    }
}
DI void p3_vt(const Ctx& F) {
    const bf16_t* __restrict__ proj = (const bf16_t*)(F.ws + WS_PROJ);
#pragma unroll 2
    for (long i = F.gtid; i < (long)NBH * 8 * 512 * 64; i += F.GT) { const int d = (int)(i & 63), t8 = (int)((i >> 6) & 511), hv = (int)((i >> 15) & 7), b = (int)(i >> 18);
        const int col = hv < 2 ? C_NKV + 256 + 128 + hv * 64 : (hv < 4 ? C_NKV + 512 + 128 + (hv - 2) * 64 : C_SB + 512 + (hv - 4) * 64);
        const bf16_t* src = proj + ((size_t)b * S + t8 * 8) * NP + col + d;
        unsigned short e[8];
#pragma unroll
        for (int j = 0; j < 8; ++j) e[j] = src[(size_t)j * NP];
        bf16_t* base = hv < 2 ? (bf16_t*)(F.ws + WS_VTS) + ((size_t)b * 2 + hv) * 64 * S : (hv < 4 ? (bf16_t*)(F.ws + WS_VTW) + ((size_t)b * 2 + hv - 2) * 64 * S : (bf16_t*)(F.ws + WS_VTB) + ((size_t)b * 4 + hv - 4) * 64 * S);
        bf16_t* dst = base + (size_t)(t8 >> 3) * 4096 + (((((t8 >> 2) & 1) * 2 + ((t8 >> 1) & 1)) * 2 + (d >> 5)) * 64 + (d & 31)) * 8 + (t8 & 1) * 4;
        *(u32x2*)dst = (u32x2){e[0] | ((unsigned)e[1] << 16), e[2] | ((unsigned)e[3] << 16)};
        *(u32x2*)(dst + 32 * 8) = (u32x2){e[4] | ((unsigned)e[5] << 16), e[6] | ((unsigned)e[7] << 16)}; }
#pragma unroll 4
    for (long i = F.gtid; i < (long)NBH * 4 * S * 8; i += F.GT) { const int d8 = (int)(i & 7), t = (int)((i >> 3) & 4095), hq = (int)((i >> 15) & 3), b = (int)(i >> 17);
        u32x4 v = *(const u32x4*)(proj + ((size_t)b * S + t) * NP + C_SB + 256 + hq * 64 + d8 * 8);
        { float f[8]; unpack8(v, f); v.x = cvtpk(f[0] * (0.125f * LOG2E), f[1] * (0.125f * LOG2E)); v.y = cvtpk(f[2] * (0.125f * LOG2E), f[3] * (0.125f * LOG2E)); v.z = cvtpk(f[4] * (0.125f * LOG2E), f[5] * (0.125f * LOG2E)); v.w = cvtpk(f[6] * (0.125f * LOG2E), f[7] * (0.125f * LOG2E)); }
        bf16_t* dst = (bf16_t*)(F.ws + WS_KB) + ((size_t)b * 4 + hq) * S * 64 + (size_t)(t >> 6) * 4096 + ((((t >> 5) & 1) * 4 + (d8 >> 1)) * 64 + (d8 & 1) * 32 + (t & 31)) * 8;
        *(u32x4*)dst = v; }
}
DI void p3_conv_relayout(const Ctx& F, const Args& a, int l) {
    const bf16_t* __restrict__ proj = (const bf16_t*)(F.ws + WS_PROJ); bf16_t* __restrict__ outs = (bf16_t*)(F.ws + WS_OUTS); bf16_t* __restrict__ ux = (bf16_t*)(F.ws + WS_UX);
    const float* __restrict__ cw = a.in[8] + l * 768;
#pragma unroll 1
    for (long i = F.gtid; i < (long)TH * 32; i += F.GT) { const int c0 = (int)(i & 31) * 8; const int tok = (int)(i >> 5), s = tok & 4095;
        const bf16_t* pr = proj + (size_t)tok * NP + C_SC + c0;
        float bg[8], u0[8], u1[8], u2[8], xi[8], z[8];
        unpack8(*(const u32x4*)pr, bg); unpack8(*(const u32x4*)(pr + 256), u2); unpack8(*(const u32x4*)(pr + 512), xi); unpack8(*(const u32x4*)(pr + (C_SCZ - C_SC)), z);
#pragma unroll
        for (int e = 0; e < 8; ++e) { u2[e] *= xi[e]; u1[e] = 0.f; u0[e] = 0.f; }
        if (s >= 1) { unpack8(*(const u32x4*)(pr - NP + 256), u1); unpack8(*(const u32x4*)(pr - NP + 512), xi);
#pragma unroll
            for (int e = 0; e < 8; ++e) u1[e] *= xi[e]; }
        if (s >= 2) { unpack8(*(const u32x4*)(pr - 2 * NP + 256), u0); unpack8(*(const u32x4*)(pr - 2 * NP + 512), xi);
#pragma unroll
            for (int e = 0; e < 8; ++e) u0[e] *= xi[e]; }
        float v[8];
#pragma unroll
        for (int e = 0; e < 8; ++e) v[e] = bg[e] * (cw[c0 + e] * u0[e] + cw[256 + c0 + e] * u1[e] + cw[512 + c0 + e] * u2[e]) * z[e];
        u32x4 w; w.x = cvtpk(v[0], v[1]); w.y = cvtpk(v[2], v[3]); w.z = cvtpk(v[4], v[5]); w.w = cvtpk(v[6], v[7]);
        *(u32x4*)(outs + (size_t)tok * DM + 256 + c0) = w; }
#pragma unroll 2
    for (long i = F.gtid; i < (long)TH * 16; i += F.GT) { const int g = (int)(i & 15); const int tok = (int)(i >> 4), b = tok >> 12, s = tok & 4095, ch = s >> 6, tt = s & 63;
        const u32x4* src = (const u32x4*)(proj + (size_t)tok * NP + C_S5U + g * 16);
        u32x4* dst = (u32x4*)(ux + ((size_t)g * 256 + b * 64 + ch) * 1152 + tt * 16);
        dst[0] = src[0]; dst[1] = src[1]; }
}
DI void p3_compress(const Ctx& F, const Args& a, int l, int half) {
    const bf16_t* proj = (const bf16_t*)(F.ws + WS_PROJ); const bf16_t* w1t = (const bf16_t*)(F.ws + WS_CW1T);
    const float* bias1 = (const float*)(F.ws + WS_CTL + 32768); const int* pos = (const int*)a.in[1];
    LAS float* part = (LAS float*)F.lds; LAS float* hbuf = (LAS float*)(F.lds + 32768);
    const int lane = F.lane, w = F.wave, fr = lane & 15, fq = lane >> 4;
    for (int item = blockIdx.x; item < 256; item += F.G) {
        const int j = item >> 7, rt = item & 127, lj = l * 2 + j;
        { int R = rt * 16 + fr; if (R > 2039) R = 2039; const int kh = R & 1, bn = R >> 1, n = bn % 255, b = bn / 255;
          const bf16_t* arow = proj + ((size_t)b * S + 16 * n) * NP + C_NKV + j * 128 + kh * 64;
          f32x4 acc[4];
#pragma unroll
          for (int q = 0; q < 4; ++q) acc[q] = (f32x4){0.f, 0.f, 0.f, 0.f};
#pragma unroll
          for (int ks = 0; ks < 8; ++ks) { const int lrow = 4 * w + (ks >> 1), d0 = (ks & 1) * 32 + 8 * fq;
              const bf16x8 av = *(const bf16x8*)(arow + (size_t)lrow * NP + d0);
#pragma unroll
              for (int q = 0; q < 4; ++q) { const bf16x8 bv = *(const bf16x8*)(w1t + ((size_t)lj * 64 + q * 16 + fr) * 2048 + 256 * w + 32 * ks + 8 * fq);
                  acc[q] = __builtin_amdgcn_mfma_f32_16x16x32_bf16(av, bv, acc[q], 0, 0, 0); } }
#pragma unroll
          for (int q = 0; q < 4; ++q)
#pragma unroll
              for (int e = 0; e < 4; ++e) part[(w * 16 + 4 * fq + e) * 64 + q * 16 + fr] = acc[q][e]; }
        __syncthreads();
        const int row = F.tid >> 5, op = F.tid & 31;
        { float s0 = 0.f, s1 = 0.f;
#pragma unroll
          for (int kc = 0; kc < 16; ++kc) { s0 += bias1[(lj * 16 + kc) * 64 + 2 * op]; s1 += bias1[(lj * 16 + kc) * 64 + 2 * op + 1]; }
#pragma unroll
          for (int ww = 0; ww < 8; ++ww) { s0 += part[(ww * 16 + row) * 64 + 2 * op]; s1 += part[(ww * 16 + row) * 64 + 2 * op + 1]; }
          hbuf[row * 64 + 2 * op] = s0 * sigm(s0); hbuf[row * 64 + 2 * op + 1] = s1 * sigm(s1); }
        __syncthreads();
        { const float* w2 = a.in[7] + (size_t)lj * 4096; float o0 = 0.f, o1 = 0.f;
          for (int o = 0; o < 64; ++o) { const float hv = hbuf[row * 64 + o]; o0 += hv * w2[o * 64 + 2 * op]; o1 += hv * w2[o * 64 + 2 * op + 1]; }
          const int R = rt * 16 + row; const bool valid = R < 2040; const int Rc = valid ? R : 2039; const int kh = Rc & 1, bn = Rc >> 1, n = bn % 255, b = bn / 255;
          if (j == 0) {
              float ss = o0 * o0 + o1 * o1;
#pragma unroll
              for (int o = 1; o < 32; o <<= 1) ss += __shfl_xor(ss, o);
              const float rs = __builtin_amdgcn_rsqf(ss * (1.f / 64.f) + EPS); const float* g1 = a.in[4] + l * 256 + 64;
              const float y0 = o0 * rs * g1[2 * op], y1 = o1 * rs * g1[2 * op + 1];
              const float p0 = __shfl_xor(y0, 16), p1 = __shfl_xor(y1, 16);
              const float ps = (float)pos[(half * NBH + b) * S + 16 * n + 31];
              const int i0 = (2 * op) & 31; float sn0, cs0, sn1, cs1;
              sincos_acc(ps * ex2(-(float)i0 * (13.287712379549449f / 32.f)), sn0, cs0); sincos_acc(ps * ex2(-(float)(i0 + 1) * (13.287712379549449f / 32.f)), sn1, cs1);
              float r0, r1; if (op < 16) { r0 = y0 * cs0 - p0 * sn0; r1 = y1 * cs1 - p1 * sn1; } else { r0 = y0 * cs0 + p0 * sn0; r1 = y1 * cs1 + p1 * sn1; }
              if (valid) { const int d = 2 * op; *(unsigned*)((bf16_t*)(F.ws + WS_KC) + ((size_t)b * 2 + kh) * 256 * 64 + (size_t)(n >> 6) * 4096 + ((((n >> 5) & 1) * 4 + (d >> 4)) * 64 + ((d >> 3) & 1) * 32 + (n & 31)) * 8 + (d & 7)) = cvtpk(r0, r1); }
          } else if (valid) { const int kk = n & 31; bf16_t* vb = (bf16_t*)(F.ws + WS_VCT) + ((size_t)b * 2 + kh) * 64 * 256 + (size_t)(n >> 6) * 4096 + ((kk >> 3) & 1) * 4 + (kk & 3);
              const int frag = (((n >> 5) & 1) * 2 + (kk >> 4)) * 2, hh = (kk >> 2) & 1;
              { const int d = 2 * op;     vb[((frag + (d >> 5)) * 64 + hh * 32 + (d & 31)) * 8] = f2bf(o0); }
              { const int d = 2 * op + 1; vb[((frag + (d >> 5)) * 64 + hh * 32 + (d & 31)) * 8] = f2bf(o1); } }
        }
        __syncthreads();
    }
}

DI f32x16 mfma32(bf16x8 a, bf16x8 b, f32x16 c) { return __builtin_amdgcn_mfma_f32_32x32x16_bf16(a, b, c, 0, 0, 0); }
DI f32x16 zero16() { f32x16 z;
#pragma unroll
    for (int i = 0; i < 16; ++i) z[i] = 0.f;
    return z; }
struct QF { bf16x8 q[4]; };
DI QF load_q(const bf16_t* Qrow  , int h) { QF f;
#pragma unroll
    for (int s = 0; s < 4; ++s) f.q[s] = *(const bf16x8*)(Qrow + 16 * s + 8 * h);
    return f; }
DI f32x16 qk_tile(const bf16_t* Kp  , int ldk, const QF& f, int r32, int h) {
    f32x16 st = zero16(); const bf16_t* kr = Kp + (size_t)r32 * ldk + 8 * h;
#pragma unroll
    for (int s = 0; s < 4; ++s) { const bf16x8 kf = *(const bf16x8*)(kr + 16 * s); st = mfma32(kf, f.q[s], st); }
    return st;
}
DI void pv_tile(f32x16 (&o)[2], const f32x16& p, const bf16_t* VTp  , int ldv, int r32, int h) {
#pragma unroll
    for (int s = 0; s < 2; ++s) {
        u32x4 pk; pk.x = cvtpk(p[8 * s + 0], p[8 * s + 1]); pk.y = cvtpk(p[8 * s + 2], p[8 * s + 3]); pk.z = cvtpk(p[8 * s + 4], p[8 * s + 5]); pk.w = cvtpk(p[8 * s + 6], p[8 * s + 7]);
        const bf16x8 pb = __builtin_bit_cast(bf16x8, pk);
#pragma unroll
        for (int dt = 0; dt < 2; ++dt) { const bf16_t* vr = VTp + (size_t)(dt * 32 + r32) * ldv + 16 * s + 4 * h;
            const s16x4 lo = *(const s16x4*)vr, hi = *(const s16x4*)(vr + 8);
            const bf16x8 va = __builtin_shufflevector(lo, hi, 0, 1, 2, 3, 4, 5, 6, 7);
            o[dt] = mfma32(va, pb, o[dt]); }
    }
}
struct KF { bf16x8 a[4], b[4]; };
DI KF load_k(const bf16_t* Kt  , int lane) { KF f; const bf16_t* kr = Kt + lane * 8;
#pragma unroll
    for (int s = 0; s < 4; ++s) { f.a[s] = *(const bf16x8*)(kr + s * 512); f.b[s] = *(const bf16x8*)(kr + 2048 + s * 512); }
    return f; }
DI void qk_from(const KF& k, const QF& f, f32x16& s0, f32x16& s1) { s0 = zero16(); s1 = zero16();
#pragma unroll
    for (int s = 0; s < 4; ++s) { s0 = mfma32(k.a[s], f.q[s], s0); s1 = mfma32(k.b[s], f.q[s], s1); } }
struct VF { bf16x8 v[8]; };
DI VF load_v(const bf16_t* Vt, int lane) { VF f; const bf16_t* vr = Vt + lane * 8;
#pragma unroll
    for (int i = 0; i < 8; ++i) f.v[i] = *(const bf16x8*)(vr + i * 512);
    return f; }
DI void pv_from(f32x16 (&o)[2], const f32x16& p0, const f32x16& p1, const VF& f) {
#pragma unroll
    for (int mt = 0; mt < 2; ++mt)
#pragma unroll
        for (int s = 0; s < 2; ++s) { const f32x16& p = mt ? p1 : p0;
            u32x4 pk; pk.x = cvtpk(p[8 * s + 0], p[8 * s + 1]); pk.y = cvtpk(p[8 * s + 2], p[8 * s + 3]); pk.z = cvtpk(p[8 * s + 4], p[8 * s + 5]); pk.w = cvtpk(p[8 * s + 6], p[8 * s + 7]);
            const bf16x8 pb = __builtin_bit_cast(bf16x8, pk);
#pragma unroll
            for (int dt = 0; dt < 2; ++dt) o[dt] = mfma32(f.v[(mt * 2 + s) * 2 + dt], pb, o[dt]); }
}
DI float score_bound(const float* gq, const float* gk, int lane) {
    float a = fabsf(gq[lane]), b = fabsf(gk[lane]);
#pragma unroll
    for (int o = 1; o < 64; o <<= 1) { a = fmaxf(a, __shfl_xor(a, o)); b = fmaxf(b, __shfl_xor(b, o)); }
    return 8.f * LOG2E * 1.02f * a * b + 0.05f;
}
DI void expsum_tile(f32x16& s0, f32x16& s1, const float M, float& l) {
    float ps = 0.f;
#pragma unroll
    for (int i = 0; i < 16; ++i) { s0[i] = ex2(s0[i] - M); s1[i] = ex2(s1[i] - M); ps += s0[i] + s1[i]; }
    l += ps;
}
constexpr float NEGB = -1e30f;
DI void softmax_tile(f32x16& s0, f32x16& s1, float& m, float& l, f32x16 (&o)[2]) {
    float tm = NEGB;
#pragma unroll
    for (int i = 0; i < 16; ++i) tm = fmaxf(tm, fmaxf(s0[i], s1[i]));
    tm = fmaxf(tm, __shfl_xor(tm, 32));
    const float mn = fmaxf(m, tm), mu = fmaxf(mn, -1e20f), alpha = ex2(fmaxf(m, -1e20f) - mu);
    const bool moved = mn != m; m = mn; float ps = 0.f;
#pragma unroll
    for (int i = 0; i < 16; ++i) { s0[i] = ex2(s0[i] - mu); s1[i] = ex2(s1[i] - mu); ps += s0[i] + s1[i]; }
    l = l * alpha + ps;
    if (__ballot(moved) != 0ull) { asm volatile("" ::: "memory");
#pragma unroll
        for (int i = 0; i < 16; ++i) { o[0][i] *= alpha; o[1][i] *= alpha; } }
}
#define KEY_OF(mt, i) (32 * (mt) + ((i) & 3) + 8 * ((i) >> 2) + 4 * h)

DI void attn_win(const Ctx& F, int b, int hq, int qblk, const float* qkg) {
    const int lane = F.lane, r32 = lane & 31, h = lane >> 5, kvh = hq >> 1, q0 = qblk * 32, tq = q0 + r32;
    const bf16_t* qn = (const bf16_t*)(F.ws + WS_QN); const bf16_t* kw = (const bf16_t*)(F.ws + WS_KW) + ((size_t)b * 2 + kvh) * S * 64;
    const bf16_t* vt = (const bf16_t*)(F.ws + WS_VTW) + ((size_t)b * 2 + kvh) * 64 * S;
    const QF qf = load_q(qn + ((size_t)b * S + tq) * 256 + hq * 64, h);
    f32x16 o[2] = {zero16(), zero16()}; float l = 0.f; const float M = score_bound(qkg, qkg + 192, lane);
    const int lo = q0 - 511 > 0 ? (q0 - 511) >> 6 : 0, hi = (q0 + 31) >> 6;
    KF kcur = load_k(kw + (size_t)lo * 4096, lane);
    for (int kt = lo; kt <= hi; ++kt) { const int key0 = kt * 64;
        const VF vf = load_v(vt + (size_t)kt * 4096, lane);
        const KF knxt = load_k(kw + (size_t)(kt < hi ? kt + 1 : kt) * 4096, lane);
        f32x16 s0, s1; qk_from(kcur, qf, s0, s1); kcur = knxt;
        if (key0 + 63 > q0 || key0 <= q0 + 31 - 512) { int tqq = tq; asm volatile("" : "+v"(tqq));
#pragma unroll
            for (int i = 0; i < 16; ++i) { const int k0 = key0 + KEY_OF(0, i), k1 = key0 + KEY_OF(1, i);
                if (!(k0 <= tqq && k0 > tqq - 512)) s0[i] = NEGB; if (!(k1 <= tqq && k1 > tqq - 512)) s1[i] = NEGB; } }
        expsum_tile(s0, s1, M, l);
        pv_from(o, s0, s1, vf);
    }
    l += __shfl_xor(l, 32); const float inv = 1.f / fmaxf(l, 1e-30f);
    bf16_t* ow = (bf16_t*)(F.ws + WS_OWIN) + ((size_t)b * S + tq) * 256 + hq * 64;
#pragma unroll
    for (int dt = 0; dt < 2; ++dt)
#pragma unroll
        for (int g4 = 0; g4 < 4; ++g4) { const int d0 = 32 * dt + 8 * g4 + 4 * h;
            *(u32x2*)(ow + d0) = (u32x2){cvtpk(o[dt][4 * g4] * inv, o[dt][4 * g4 + 1] * inv), cvtpk(o[dt][4 * g4 + 2] * inv, o[dt][4 * g4 + 3] * inv)}; }
}
DI void attn_slc(const Ctx& F, int b, int hq, int qblk, const float* qkg) {
    const int lane = F.lane, r32 = lane & 31, h = lane >> 5, kvh = hq >> 1, q0 = qblk * 32, tq = q0 + r32;
    const bf16_t* qn = (const bf16_t*)(F.ws + WS_QN); const bf16_t* ks = (const bf16_t*)(F.ws + WS_KS) + ((size_t)b * 2 + kvh) * S * 64;
    const bf16_t* vt = (const bf16_t*)(F.ws + WS_VTS) + ((size_t)b * 2 + kvh) * 64 * S;
    const unsigned long long mk = ((const unsigned long long*)(F.ws + WS_SEL))[((size_t)b * S + tq) * 2 + kvh];
    const QF qf = load_q(qn + ((size_t)b * S + tq) * 256 + hq * 64, h);
    f32x16 o[2] = {zero16(), zero16()}; float l = 0.f; const float M = score_bound(qkg, qkg + 128, lane);
    if (qblk >= 96) __builtin_amdgcn_s_setprio(2); else if (qblk >= 48) __builtin_amdgcn_s_setprio(1);
    const int hi = (q0 + 31) >> 6;
    unsigned ulo = (unsigned)mk, uhi = (unsigned)(mk >> 32);
#pragma unroll
    for (int o_ = 1; o_ < 64; o_ <<= 1) { ulo |= (unsigned)__shfl_xor((int)ulo, o_); uhi |= (unsigned)__shfl_xor((int)uhi, o_); }
    unsigned long long rem = ((unsigned long long)(unsigned)__builtin_amdgcn_readfirstlane((int)uhi) << 32) | (unsigned)__builtin_amdgcn_readfirstlane((int)ulo);
    rem &= (hi >= 63) ? ~0ull : ((1ull << (hi + 1)) - 1ull);
    KF kcur = load_k(ks + (size_t)__builtin_ctzll(rem) * 4096, lane);
    while (rem) { const int kt = __builtin_ctzll(rem); rem &= rem - 1ull; const int key0 = kt * 64; const bool bit = (mk >> kt) & 1ull;
        const VF vf = load_v(vt + (size_t)kt * 4096, lane);
        const KF knxt = load_k(ks + (size_t)(rem ? __builtin_ctzll(rem) : kt) * 4096, lane);
        f32x16 s0, s1; qk_from(kcur, qf, s0, s1); kcur = knxt;
        const bool diag = key0 + 63 > q0;
        if (diag) { int tqq = tq; asm volatile("" : "+v"(tqq));
#pragma unroll
            for (int i = 0; i < 16; ++i) { const int k0 = key0 + KEY_OF(0, i), k1 = key0 + KEY_OF(1, i); s0[i] = k0 > tqq ? NEGB : s0[i]; s1[i] = k1 > tqq ? NEGB : s1[i]; } }
        if (__ballot(!bit) != 0ull) { float ng = NEGB; asm volatile("" : "+v"(ng));
#pragma unroll
            for (int i = 0; i < 16; ++i) { s0[i] = bit ? s0[i] : ng; s1[i] = bit ? s1[i] : ng; } }
        expsum_tile(s0, s1, M, l);
        pv_from(o, s0, s1, vf);
    }
    __builtin_amdgcn_s_setprio(0);
    l += __shfl_xor(l, 32); const float inv = 1.f / fmaxf(l, 1e-30f);
    const size_t tok = (size_t)b * S + tq;
    const float* g12 = (const float*)(F.ws + WS_G12) + tok * 12; const float gc = g12[hq], gs = g12[4 + hq] * inv, gw = g12[8 + hq];
    const bf16_t* oc = (const bf16_t*)(F.ws + WS_OCMP) + tok * 256 + hq * 64; const bf16_t* ow = (const bf16_t*)(F.ws + WS_OWIN) + tok * 256 + hq * 64;
    const bf16_t* zz = (const bf16_t*)(F.ws + WS_PROJ) + tok * NP + C_NZ + hq * 64; bf16_t* outs = (bf16_t*)(F.ws + WS_OUTS) + tok * DM + hq * 64;
#pragma unroll
    for (int dt = 0; dt < 2; ++dt)
#pragma unroll
        for (int g4 = 0; g4 < 4; ++g4) { const int d0 = 32 * dt + 8 * g4 + 4 * h; float c4[4], w4[4], z4[4], v[4];
            unpack4(*(const u32x2*)(oc + d0), c4); unpack4(*(const u32x2*)(ow + d0), w4); unpack4(*(const u32x2*)(zz + d0), z4);
#pragma unroll
            for (int e = 0; e < 4; ++e) v[e] = (gc * c4[e] + gs * o[dt][4 * g4 + e] + gw * w4[e]) * z4[e];
            *(u32x2*)(outs + d0) = (u32x2){cvtpk(v[0], v[1]), cvtpk(v[2], v[3])}; }
}
DI void attn_sb(const Ctx& F, int b, int hq, int qblk) {
    const int lane = F.lane, r32 = lane & 31, h = lane >> 5, q0 = qblk * 32, tq = q0 + r32;
    const bf16_t* proj = (const bf16_t*)(F.ws + WS_PROJ) + (size_t)b * S * NP;
    const bf16_t* kp = (const bf16_t*)(F.ws + WS_KB) + ((size_t)b * 4 + hq) * S * 64; const bf16_t* vt = (const bf16_t*)(F.ws + WS_VTB) + ((size_t)b * 4 + hq) * 64 * S;
    const QF qf = load_q(proj + (size_t)tq * NP + C_SB + hq * 64, h);
    if (qblk >= 96) __builtin_amdgcn_s_setprio(3); else if (qblk >= 64) __builtin_amdgcn_s_setprio(2); else if (qblk >= 32) __builtin_amdgcn_s_setprio(1);
    f32x16 o[2] = {zero16(), zero16()}; float carry = 1.f;
    KF kcur = load_k(kp + (size_t)((q0 + 31) >> 6) * 4096, lane);
    for (int kt = (q0 + 31) >> 6; kt >= 0; --kt) { const int key0 = kt * 64;
        const VF vf = load_v(vt + (size_t)kt * 4096, lane);
        const KF knxt = load_k(kp + (size_t)(kt > 0 ? kt - 1 : kt) * 4096, lane);
        f32x16 s0, s1; qk_from(kcur, qf, s0, s1); kcur = knxt;
        const bool diag = key0 + 63 >= q0;
        f32x16 u0, u1;
#pragma unroll
        for (int i = 0; i < 16; ++i) {
            const float e0 = ex2(__builtin_amdgcn_fmed3f(s0[i], -126.f, 80.f)), e1 = ex2(__builtin_amdgcn_fmed3f(s1[i], -126.f, 80.f));
            const float a0_ = __builtin_amdgcn_rcpf(1.f + e0), a1_ = __builtin_amdgcn_rcpf(1.f + e1);
            u0[i] = a0_; u1[i] = a1_; s0[i] = e0 * a0_; s1[i] = e1 * a1_; }
        if (diag) { int tqq = tq; asm volatile("" : "+v"(tqq));
#pragma unroll
            for (int i = 0; i < 16; ++i) { const bool m0 = key0 + KEY_OF(0, i) >= tqq, m1 = key0 + KEY_OF(1, i) >= tqq;
                u0[i] = m0 ? 1.f : u0[i]; s0[i] = m0 ? 0.f : s0[i]; u1[i] = m1 ? 1.f : u1[i]; s1[i] = m1 ? 0.f : s1[i]; } }
        float G[8], R[8];
#pragma unroll
        for (int g4 = 0; g4 < 4; ++g4) { G[g4] = (u0[4 * g4] * u0[4 * g4 + 1]) * (u0[4 * g4 + 2] * u0[4 * g4 + 3]); G[4 + g4] = (u1[4 * g4] * u1[4 * g4 + 1]) * (u1[4 * g4 + 2] * u1[4 * g4 + 3]); }
#pragma unroll
        for (int q = 0; q < 8; ++q) R[q] = __shfl_xor(G[q], 32);
        float after = carry;
#pragma unroll
        for (int q = 7; q >= 0; --q) {
            float c = after * (h == 0 ? R[q] : 1.f);
            if (q < 4) { const int g4 = q;
#pragma unroll
                for (int e = 3; e >= 0; --e) { const float w = s0[4 * g4 + e] * c; c *= u0[4 * g4 + e]; s0[4 * g4 + e] = w; } }
            else { const int g4 = q - 4;
#pragma unroll
                for (int e = 3; e >= 0; --e) { const float w = s1[4 * g4 + e] * c; c *= u1[4 * g4 + e]; s1[4 * g4 + e] = w; } }
            after *= G[q] * R[q]; }
        carry = after;
        pv_from(o, s0, s1, vf);
    }
    __builtin_amdgcn_s_setprio(0);
    const size_t tok = (size_t)b * S + tq;
    const bf16_t* zz = (const bf16_t*)(F.ws + WS_PROJ) + tok * NP + C_SBZ + hq * 64; bf16_t* outs = (bf16_t*)(F.ws + WS_OUTS) + tok * DM + 512 + hq * 64;
#pragma unroll
    for (int dt = 0; dt < 2; ++dt)
#pragma unroll
        for (int g4 = 0; g4 < 4; ++g4) { const int d0 = 32 * dt + 8 * g4 + 4 * h; float z4[4]; unpack4(*(const u32x2*)(zz + d0), z4);
            *(u32x2*)(outs + d0) = (u32x2){cvtpk(o[dt][4 * g4] * z4[0], o[dt][4 * g4 + 1] * z4[1]), cvtpk(o[dt][4 * g4 + 2] * z4[2], o[dt][4 * g4 + 3] * z4[3])}; }
}
DI void attn_cmp(const Ctx& F, int b, int kvh, int qblk, const float* qkg) {
    const int lane = F.lane, r32 = lane & 31, h = lane >> 5, q0 = qblk * 32, tq = q0 + r32;
    const bf16_t* qn = (const bf16_t*)(F.ws + WS_QN); const bf16_t* kc = (const bf16_t*)(F.ws + WS_KC) + ((size_t)b * 2 + kvh) * 256 * 64;
    const bf16_t* vt = (const bf16_t*)(F.ws + WS_VCT) + ((size_t)b * 2 + kvh) * 64 * 256;
    const int ntile = ((q0 >> 4) >> 6) + 1; const int nlim = (tq - 31) >> 4, nlim0 = (q0 - 31) >> 4;
    LAS float* ib = (LAS float*)(F.lds + F.wave * 8192);
    const float M = score_bound(qkg, qkg + 64, lane);
#pragma unroll
    for (int t = 0; t < 32; ++t) ib[r32 * 64 + 2 * t + h] = 0.f;
#pragma unroll 1
    for (int g = 0; g < 2; ++g) { const int hq = kvh * 2 + g;
        const QF qf = load_q(qn + ((size_t)b * S + tq) * 256 + hq * 64, h);
        float l = 0.f;
        KF kcur = load_k(kc, lane);
#pragma unroll 1
        for (int kt = 0; kt < ntile; ++kt) { const int key0 = kt * 64;
            const KF knxt = load_k(kc + (size_t)(kt + 1 < ntile ? kt + 1 : kt) * 4096, lane);
            f32x16 s0, s1; qk_from(kcur, qf, s0, s1); kcur = knxt;
            if (key0 + 63 > nlim0) { int nl = nlim; asm volatile("" : "+v"(nl));
#pragma unroll
                for (int i = 0; i < 16; ++i) { if (key0 + KEY_OF(0, i) > nl) s0[i] = NEGB; if (key0 + KEY_OF(1, i) > nl) s1[i] = NEGB; } }
            float ps = 0.f;
#pragma unroll
            for (int i = 0; i < 16; ++i) ps += ex2(s0[i] - M) + ex2(s1[i] - M);
            l += ps; }
        l += __shfl_xor(l, 32); const float inv = __builtin_amdgcn_rcpf(fmaxf(l, 1e-30f)), mu = M;
        f32x16 o[2] = {zero16(), zero16()}; float prevlast = 0.f;
        kcur = load_k(kc, lane);
#pragma unroll 1
        for (int kt = 0; kt < ntile; ++kt) { const int key0 = kt * 64;
            const VF vf = load_v(vt + (size_t)kt * 4096, lane);
            const KF knxt = load_k(kc + (size_t)(kt + 1 < ntile ? kt + 1 : kt) * 4096, lane);
            f32x16 s0, s1; qk_from(kcur, qf, s0, s1); kcur = knxt;
#pragma unroll
            for (int i = 0; i < 16; ++i) { s0[i] = ex2(s0[i] - mu) * inv; s1[i] = ex2(s1[i] - mu) * inv; }
            if (key0 + 63 > nlim0) { int nl = nlim; asm volatile("" : "+v"(nl));
#pragma unroll
                for (int i = 0; i < 16; ++i) { if (key0 + KEY_OF(0, i) > nl) s0[i] = 0.f; if (key0 + KEY_OF(1, i) > nl) s1[i] = 0.f; } }
            float R[8];
#pragma unroll
            for (int g4 = 0; g4 < 4; ++g4) { R[g4] = __shfl_xor(s0[4 * g4 + 3], 32); R[4 + g4] = __shfl_xor(s1[4 * g4 + 3], 32); }
#pragma unroll
            for (int q = 0; q < 8; ++q) { float gs = (q < 4) ? (s0[4 * q] + s0[4 * q + 1]) + (s0[4 * q + 2] + s0[4 * q + 3]) : (s1[4 * (q - 4)] + s1[4 * (q - 4) + 1]) + (s1[4 * (q - 4) + 2] + s1[4 * (q - 4) + 3]);
                const float ex = (h == 1) ? R[q] : (q == 0 ? prevlast : R[q - 1]);
                ib[r32 * 64 + 16 * kt + 2 * q + h] += gs + ex; }
            prevlast = R[7];
            pv_from(o, s0, s1, vf); }
        bf16_t* oc = (bf16_t*)(F.ws + WS_OCMP) + ((size_t)b * S + tq) * 256 + hq * 64;
#pragma unroll
        for (int dt = 0; dt < 2; ++dt)
#pragma unroll
            for (int g4 = 0; g4 < 4; ++g4) { const int d0 = 32 * dt + 8 * g4 + 4 * h;
                *(u32x2*)(oc + d0) = (u32x2){cvtpk(o[dt][4 * g4], o[dt][4 * g4 + 1]), cvtpk(o[dt][4 * g4 + 2], o[dt][4 * g4 + 3])}; }
    }
    LDS_WAIT();
    unsigned long long* sel = (unsigned long long*)(F.ws + WS_SEL);
#pragma unroll 1
    for (int qq = 0; qq < 32; qq += 8) {
        unsigned key[8], prefix[8];
#pragma unroll
        for (int u = 0; u < 8; ++u) { const int t = q0 + qq + u, cur = t >> 6, j = lane;
            const float v = ib[(qq + u) * 64 + lane];
            const float val = (j == 0 || j == cur || j == cur - 1) ? 1.0e4f : (j <= cur ? v : -1.0e4f);
            const unsigned vb_ = __float_as_uint(val); key[u] = vb_ ^ ((vb_ >> 31) ? 0xFFFFFFFFu : 0x80000000u); prefix[u] = 0u; }
#pragma unroll 1
        for (int bit = 31; bit >= 0; --bit) {
#pragma unroll
            for (int u = 0; u < 8; ++u) { const unsigned cand = prefix[u] | (1u << bit); if (__popcll(__ballot(key[u] >= cand)) >= 16) prefix[u] = cand; } }
#pragma unroll
        for (int u = 0; u < 8; ++u) { const int t = q0 + qq + u;
            unsigned long long mk = __ballot(key[u] > prefix[u]), eq = __ballot(key[u] == prefix[u]); int need = 16 - (int)__popcll(mk);
            while (need-- > 0) { const unsigned long long lb = eq & (0ull - eq); mk |= lb; eq ^= lb; }
            if (lane == 0) sel[((size_t)b * S + t) * 2 + kvh] = mk; } }
    LDS_WAIT();
}
DI int grab(unsigned* ctr, int lane) { int v = 0; if (lane == 0) v = (int)atomicAdd(ctr, 1u); return __builtin_amdgcn_readfirstlane(v); }

DI void s5_scan(const Ctx& F, int l, int g) {
    VM_WAIT(); __syncthreads();
    if (F.tid < 256) { const int b = F.tid >> 6, p = F.tid & 63; const f32x2 a64 = ((const f32x2*)(F.ws + WS_POW))[((size_t)(l * 16 + g) * 64 + p) * 65 + 64];
        const float* stl = (const float*)(F.ws + WS_STL) + ((size_t)g * 256 + b * 64) * 128 + p; bf16_t* ux = (bf16_t*)(F.ws + WS_UX) + ((size_t)g * 256 + b * 64) * 1152 + 1024 + p;
        float xr = 0.f, xi = 0.f;
#pragma unroll 1
        for (int c0 = 0; c0 < 64; c0 += 16) { float lr[16], li[16];
#pragma unroll
            for (int j = 0; j < 16; ++j) { lr[j] = stl[(size_t)(c0 + j) * 128]; li[j] = stl[(size_t)(c0 + j) * 128 + 64]; }
#pragma unroll
            for (int j = 0; j < 16; ++j) { ux[(size_t)(c0 + j) * 1152] = f2bf(xr); ux[(size_t)(c0 + j) * 1152 + 64] = f2bf(xi);
                const float nr = a64.x * xr - a64.y * xi + lr[j], ni = a64.x * xi + a64.y * xr + li[j]; xr = nr; xi = ni; } } }
    VM_WAIT(); __syncthreads();
}

#if !defined(ONLY_ATT) || ONLY_ATT==0
#define ATT0(x) x
#else
#define ATT0(x) do{}while(0)
#endif
#if !defined(ONLY_ATT) || ONLY_ATT==1
#define ATT1(x) x
#else
#define ATT1(x) do{}while(0)
#endif
#if !defined(ONLY_ATT) || ONLY_ATT==2
#define ATT2(x) x
#else
#define ATT2(x) do{}while(0)
#endif
#if !defined(ONLY_ATT) || ONLY_ATT==3
#define ATT3(x) x
#else
#define ATT3(x) do{}while(0)
#endif
#if !defined(NO_GEMM) && (!defined(ONLY_GEMM) || ONLY_GEMM==0)
#define GEMM_CALL0(a,b,c,d) pg8::gemm_phase<C>(a,b,c,d)
#else
#define GEMM_CALL0(a,b,c,d) do{}while(0)
#endif
#if !defined(NO_GEMM) && (!defined(ONLY_GEMM) || ONLY_GEMM==1)
#define GEMM_CALL1(a,b,c,d) pg8::gemm_phase<C>(a,b,c,d)
#else
#define GEMM_CALL1(a,b,c,d) do{}while(0)
#endif
#if !defined(NO_GEMM) && (!defined(ONLY_GEMM) || ONLY_GEMM==2)
#define GEMM_CALL2(a,b,c,d) pg8::gemm_phase<C>(a,b,c,d)
#else
#define GEMM_CALL2(a,b,c,d) do{}while(0)
#endif
#if !defined(NO_GEMM) && (!defined(ONLY_GEMM) || ONLY_GEMM==3)
#define GEMM_CALL3(a,b,c,d) pg8::gemm_phase<C>(a,b,c,d)
#else
#define GEMM_CALL3(a,b,c,d) do{}while(0)
#endif
#if !defined(NO_GEMM) && (!defined(ONLY_GEMM) || ONLY_GEMM==4)
#define GEMM_CALL4(a,b,c,d) pg8::gemm_phase<C>(a,b,c,d)
#else
#define GEMM_CALL4(a,b,c,d) do{}while(0)
#endif
#if !defined(NO_GEMM) && (!defined(ONLY_GEMM) || ONLY_GEMM==5)
#define GEMM_CALL5(a,b,c,d) pg8::gemm_phase<C>(a,b,c,d)
#else
#define GEMM_CALL5(a,b,c,d) do{}while(0)
#endif
__global__ void __launch_bounds__(NTHR, 2) mega(Args a) {
    extern __shared__ __attribute__((aligned(16))) unsigned char lds_raw[];
    cg::grid_group grid = cg::this_grid();
#define MKCTX() Ctx F = mkctx(a.ws, (LAS unsigned char*)lds_raw)
    unsigned char* ws = a.ws; unsigned* ctl = (unsigned*)(ws + WS_CTL);
    const int c = blockIdx.x, G = gridDim.x;
    if (threadIdx.x < 8) ((volatile LAS unsigned*)(lds_raw + MISC_OFF))[threadIdx.x] = 0u;
    __syncthreads();
    const XcdBarrier xbar = xcd_barrier_post(ctl + CW_BAR, (volatile LAS unsigned*)((LAS unsigned char*)lds_raw + MISC_OFF));
#define GSYNC() xcd_barrier(xbar)
#define LDSP ((LAS unsigned char*)lds_raw)

#ifndef NO_K1
    { MKCTX(); k1_prologue(F, a); }
#endif
    grid.sync();
    for (int l = 0; l < 2; ++l) {
        for (int half = 0; half < 2; ++half) {
            const float* xin = (l == 0 ? a.in[0] : a.out) + (size_t)half * TH * DM; float* xout = a.out + (size_t)half * TH * DM;
#ifndef NO_P1
            { MKCTX(); if (l == 0 && half == 0) kmat_build(F, a);
            p1_pre(F, xin, l); }
#endif
            GSYNC();
            { using C = pg8::Cfg<DM, DM, DM, 0, 0, TH / 256, NINP / 256, 1, 0>;
              pg8::Gemm g{(const bf16_t*)(ws + WS_XB), (const bf16_t*)(ws + WS_WINT) + (size_t)l * NINP * DM};
              pg8::Sched<C> Sc{G, c};
              EpiInproj E{ws};
              GEMM_CALL0(LDSP, g, Sc, E); }
            GSYNC();
#ifndef NO_P3
            { MKCTX(); p3_compress(F, a, l, half); }
            { MKCTX(); p3_qk(F, a, l, half); }
            { MKCTX(); p3_vt(F); }
            { MKCTX(); p3_conv_relayout(F, a, l); }
            if (half == 0) { MKCTX(); s5_expand(F, a, l); }
#endif
            GSYNC();
            if (c < 16 && c < G) {
                { using C = pg8::Cfg<1152, 1024, 1024, 256 * 1152, 256 * 1024, 1, 1, 16, 0>;
                  pg8::Gemm g{(const bf16_t*)(ws + WS_UX), (const bf16_t*)(ws + WS_SPG)};
                  pg8::Sched<C> Sc{16 > G ? G : 16, c};
                  EpiS5a E{ws}; GEMM_CALL1(LDSP, g, Sc, E); }
                { MKCTX(); s5_scan(F, l, c); }
            }
            { MKCTX(); const int x0 = (int)(xb_xcc_id() & 7u);
              for (int qi = 0; qi < 8; ++qi) { const int xq = (x0 + qi) & 7; unsigned* ctr = ctl + 64 * ((((l * 2 + half) * 2 + 0) * 8) + xq); const int b = xq >> 1, kvh = xq & 1;
                  for (;;) { const int idx = grab(ctr, F.lane); if (idx >= 128 + 256) break;
                      if (idx < 128) { ATT2(attn_cmp(F, b, kvh, 127 - idx, a.in[4] + l * 256)); }
                      else { const int i3 = idx - 128; ATT1(attn_win(F, b, kvh * 2 + (i3 & 1), i3 >> 1, a.in[4] + l * 256)); }
                  } } }
            GSYNC();
            { using C = pg8::Cfg<1152, 1152, 1152, 256 * 1152, 1024 * 1152, 1, 4, 16, 0>;
              pg8::Gemm g{(const bf16_t*)(ws + WS_UX), (const bf16_t*)(ws + WS_SA2)};
              pg8::Sched<C> Sc{64 > G ? G : 64, c};
              if (c < Sc.G) { EpiS5b E{ws}; GEMM_CALL2(LDSP, g, Sc, E); } }
            { MKCTX(); const int x0 = (int)(xb_xcc_id() & 7u);
              for (int qi = 0; qi < 8; ++qi) { const int xq = (x0 + qi) & 7; unsigned* ctr = ctl + 64 * ((((l * 2 + half) * 2 + 1) * 8) + xq); const int b = xq >> 1, kvh = xq & 1;
                  for (;;) { const int idx = grab(ctr, F.lane); if (idx >= 512) break;
                      const int qb = 127 - (idx >> 2), hq = kvh * 2 + (idx & 1);
                      if (idx & 2) { ATT3(attn_slc(F, b, hq, qb, a.in[4] + l * 256)); } else { ATT0(attn_sb(F, b, hq, qb)); }
                  } } }
            GSYNC();
            { using C = pg8::Cfg<256, 256, 256, 0, 0, TH / 256, 2, 1, 0>;
              pg8::Gemm g{(const bf16_t*)(ws + WS_Y5), (const bf16_t*)(ws + WS_GLUT) + (size_t)l * 512 * 256};
              pg8::Sched<C> Sc{G, c};
              EpiGlu E{ws, a.in[18] + l * 512};
              GEMM_CALL3(LDSP, g, Sc, E); }
            GSYNC();
            { using C = pg8::Cfg<DM, 512, 512, 512, 8 * 256 * 512, TH / 256, 8, 2, 1, true>;
              pg8::Gemm g{(const bf16_t*)(ws + WS_OUTS), (const bf16_t*)(ws + WS_WB2T) + (size_t)l * 2 * 8 * 256 * 512};
              pg8::Sched<C> Sc{G, c};
              EpiBranch E{ws};
              GEMM_CALL4(LDSP, g, Sc, E); }
            GSYNC();
            { using C = pg8::Cfg<DM, DM, DM, 0, 0, TH / 256, 4, 1, 0>;
              pg8::Gemm g{(const bf16_t*)(ws + WS_MIXED), (const bf16_t*)(ws + WS_WOUTT) + (size_t)l * DM * DM};
              pg8::Sched<C> Sc{G, c};
              EpiOut E{xin, xout};
              GEMM_CALL5(LDSP, g, Sc, E); }
            GSYNC();
        }
    }
}

extern "C" void kernel_launch(void* const* d_in, const int* in_sizes, int n_in, void* d_out, int out_size, void* d_ws, size_t ws_size, hipStream_t stream) {
    static int grid = 0;
    if (grid == 0) {
        if (n_in != 21 || ws_size < WS_END) { fprintf(stderr, "kernel_launch: unexpected n_in %d / ws_size %zu (need %zu)\n", n_in, ws_size, (size_t)WS_END); grid = -1; return; }
        int dev = 0, cus = 0, per_cu = 0;
        hipGetDevice(&dev); hipDeviceGetAttribute(&cus, hipDeviceAttributeMultiprocessorCount, dev);
        hipFuncSetAttribute((const void*)mega, hipFuncAttributeMaxDynamicSharedMemorySize, LDS_BYTES);
        hipOccupancyMaxActiveBlocksPerMultiprocessor(&per_cu, (const void*)mega, NTHR, LDS_BYTES);
        if (per_cu < 1) { fprintf(stderr, "kernel_launch: occupancy query says %d blocks per CU\n", per_cu); per_cu = 1; }
        grid = cus * 1;
        (void)hipGetLastError();
    }
    if (grid < 0) return;
    hipMemsetAsync((char*)d_ws + WS_CTL, 0, CTL_BYTES, stream);
    Args a{};
    for (int i = 0; i < 21; ++i) a.in[i] = (const float*)d_in[i];
    a.out = (float*)d_out; a.ws = (unsigned char*)d_ws;
    void* params[] = {&a};
    hipError_t e = hipLaunchCooperativeKernel((const void*)mega, dim3(grid), dim3(NTHR), params, LDS_BYTES, stream);
    if (e != hipSuccess) fprintf(stderr, "cooperative launch failed: %s (grid %d)\n", hipGetErrorString(e), grid);
}
```

```cpp
#include <hip/hip_runtime.h>
#include <hip/hip_cooperative_groups.h>
#include <cstdio>
#include <cstdint>
namespace cg = cooperative_groups;

#define DI __device__ __forceinline__
#define LAS __attribute__((address_space(3)))
typedef unsigned short bf16_t;
typedef short bf16x8 __attribute__((ext_vector_type(8)));
typedef short s16x4 __attribute__((ext_vector_type(4)));
typedef float f32x4 __attribute__((ext_vector_type(4)));
typedef float f32x2 __attribute__((ext_vector_type(2)));
typedef float f32x16 __attribute__((ext_vector_type(16)));
typedef unsigned u32x4 __attribute__((ext_vector_type(4)));
typedef unsigned u32x2 __attribute__((ext_vector_type(2)));
typedef __bf16 bf16x2_t __attribute__((ext_vector_type(2)));

constexpr int S = 4096, NBH = 4, TH = NBH * S, DM = 1024, NP = 3840, NGATE = 4096, NINW = 7948, NIN = 7936, NINP = 8192;
constexpr int C_NQ = 0, C_NKV = 256, C_NZ = 1024, C_SC = 1280, C_SCZ = 2048, C_SB = 2304, C_SBZ = 3072, C_S5U = 3328, C_S5Z = 3584;
constexpr float EPS = 1e-6f, LOG2E = 1.4426950408889634f;
constexpr int NWAVES = 8, NTHR = 512, LDS_BYTES = 147456;

constexpr size_t MiB = 1u << 20;
constexpr size_t WS_CTL = 0, CTL_BYTES = 128 * 1024;
constexpr size_t WS_WINT = 1 * MiB, WS_WBT = 33 * MiB, WS_WOUTT = 37 * MiB, WS_GLUT = 41 * MiB, WS_CW1T = 42 * MiB;
constexpr size_t WS_POW = 43 * MiB, WS_BBAR = 45 * MiB, WS_KMAT = 46 * MiB, WS_SPG = 48 * MiB, WS_SA2 = 56 * MiB;
constexpr size_t WS_XB = 92 * MiB, WS_RSTD = 124 * MiB, WS_G12 = 125 * MiB, WS_PROJ = 126 * MiB, WS_GATES = 246 * MiB;
constexpr size_t WS_QN = 374 * MiB, WS_KS = 382 * MiB, WS_KW = 386 * MiB, WS_VTS = 390 * MiB, WS_VTW = 394 * MiB, WS_VTB = 398 * MiB;
constexpr size_t WS_KC = 406 * MiB, WS_VCT = 406 * MiB + 512 * 1024, WS_SEL = 407 * MiB, WS_OCMP = 408 * MiB, WS_OWIN = 416 * MiB;
constexpr size_t WS_OUTS = 424 * MiB, WS_UX = 456 * MiB, WS_STL = 466 * MiB, WS_Y5 = 470 * MiB, WS_KB = 478 * MiB, WS_WB2T = 486 * MiB, WS_END = 494 * MiB;
constexpr size_t WS_TMP = WS_PROJ, WS_MIXED = WS_XB;

DI float bf2f(bf16_t v) { return __uint_as_float(((unsigned)v) << 16); }
DI unsigned cvtpk(float lo, float hi) { f32x2 v = {lo, hi}; bf16x2_t b = __builtin_convertvector(v, bf16x2_t); return __builtin_bit_cast(unsigned, b); }
DI bf16_t f2bf(float f) { return (bf16_t)(cvtpk(f, 0.f) & 0xffffu); }
DI float wave_sum(float v) {
#pragma unroll
    for (int o = 1; o < 64; o <<= 1) v += __shfl_xor(v, o);
    return v;
}
DI float sigm(float x) { return __builtin_amdgcn_rcpf(1.f + __builtin_amdgcn_exp2f(x * -1.4426950408889634f)); }
DI float ex2(float x) { return __builtin_amdgcn_exp2f(x); }
DI float lg2(float x) { return __builtin_amdgcn_logf(x); }
DI void sincos_acc(float ang, float& s, float& c) {
    double rev = (double)ang * 0.15915494309189535; float fr = (float)(rev - floor(rev));
    s = __builtin_amdgcn_sinf(fr); c = __builtin_amdgcn_cosf(fr);
}
DI void unpack8(u32x4 w, float (&f)[8]) {
    f[0] = __uint_as_float(w.x << 16); f[1] = __uint_as_float(w.x & 0xffff0000u); f[2] = __uint_as_float(w.y << 16); f[3] = __uint_as_float(w.y & 0xffff0000u);
    f[4] = __uint_as_float(w.z << 16); f[5] = __uint_as_float(w.z & 0xffff0000u); f[6] = __uint_as_float(w.w << 16); f[7] = __uint_as_float(w.w & 0xffff0000u);
}
DI void unpack4(u32x2 w, float (&f)[4]) {
    f[0] = __uint_as_float(w.x << 16); f[1] = __uint_as_float(w.x & 0xffff0000u); f[2] = __uint_as_float(w.y << 16); f[3] = __uint_as_float(w.y & 0xffff0000u);
}
#define LDS_WAIT() asm volatile("s_waitcnt lgkmcnt(0)" ::: "memory")
#define VM_WAIT() asm volatile("s_waitcnt vmcnt(0)" ::: "memory")

namespace pg8 {
constexpr int BM = 256, BK = 64, HALF = 128, HTB = HALF * BK * 2, NXCD = 8, WGM = 8;
DI int lds_byte(int r, int c) { const int st = (r >> 4) * 2 + (c >> 5), rr = r & 15, cc = c & 31, ob = rr * 64 + cc * 2; return st * 1024 + (ob ^ (((ob >> 9) & 1) << 5)); }
DI void stage_rc(int b, int& R, int& C) { const int st = b / 1024, sb = b % 1024, swz = sb ^ (((sb >> 9) & 1) << 5); R = (st >> 1) * 16 + swz / 64; C = (st & 1) * 32 + (swz % 64) / 2; }
DI int perm32(int rho) { const int n = rho >> 4, i = rho & 15; return 8 * (i >> 2) + 4 * n + (i & 3); }
struct Unit { int pm, pn, z; };
struct Gemm { const bf16_t* A; const bf16_t* Bt; };
template <int LDA_, int LDB_, int K_, long SAZ_, long SBZ_, int NM_, int NN_, int NZ_, int MODE_, bool HK_ = false> struct Cfg { static constexpr int LDA = LDA_, LDB = LDB_, K = K_, NM = NM_, NN = NN_, NZ = NZ_, MODE = MODE_; static constexpr long SAZ = SAZ_, SBZ = SBZ_; static constexpr bool HK = HK_; };
DI void tile_map(int wgid, int nM, int nN, int& pm, int& pn) {
    const int nwg = nM * nN; { const int q = nwg / NXCD, r = nwg % NXCD, xcd = wgid % NXCD, off = wgid / NXCD; wgid = (xcd < r ? xcd * (q + 1) : r * (q + 1) + (xcd - r) * q) + off; }
    const int nig = WGM * nN, gid = wgid / nig, fm = gid * WGM, gsz = (nM - fm) < WGM ? (nM - fm) : WGM;
    pm = fm + ((wgid % nig) % gsz); pn = (wgid % nig) / gsz;
}
template <class C> struct Sched {
    int G, c;
    DI bool next(int i, Unit& u) const {
        constexpr int per = C::NM * C::NN;
        if (C::MODE == 2) { if (i >= C::NN) return false; u.z = c; u.pm = 0; u.pn = i; return true; }
        if (C::MODE == 0) { const int L = i * G + c; if (L >= per * C::NZ) return false; const int z = L / per, r = L % per; u.z = z;
            if (C::NZ == 1) tile_map(r, C::NM, C::NN, u.pm, u.pn); else { u.pm = r % C::NM; u.pn = r / C::NM; } return true; }
        const int t = (i / C::NZ) * G + c; if (t >= per) return false; u.z = i % C::NZ; tile_map(t, C::NM, C::NN, u.pm, u.pn); return true;
    }
};
template <class C> DI const char* unitA(const Gemm& g, const Unit& u) { return (const char*)g.A + ((size_t)u.z * C::SAZ + (size_t)u.pm * BM * C::LDA) * 2; }
template <class C> DI const char* unitB(const Gemm& g, const Unit& u) { return (const char*)g.Bt + ((size_t)u.z * C::SBZ + (size_t)u.pn * BM * C::LDB) * 2; }

template <class C, class Epi>
DI void gemm_phase(LAS unsigned char* lds, const Gemm g, const Sched<C>& S, const Epi& E) {
    int tid_ = threadIdx.x; asm volatile("" : "+v"(tid_));
    const int tid = tid_, wid = __builtin_amdgcn_readfirstlane(tid >> 6), lane = tid & 63, wr = wid >> 2, wc = wid & 3, fr = lane & 15, fq = lane >> 4;
    constexpr int nt = C::K / BK;
    unsigned voffA[2], voffB[2];
#pragma unroll
    for (int i = 0; i < 2; ++i) { int R, Cc; stage_rc(tid * 16 + i * 8192, R, Cc); const int Rb = (R & ~31) + perm32(R & 31);
        voffA[i] = (unsigned)(R * C::LDA + Cc) * 2u; voffB[i] = (unsigned)(Rb * C::LDB + Cc) * 2u; }
    constexpr size_t kstep = (size_t)(BK * 2);
    constexpr size_t hstepA = (size_t)HALF * C::LDA * 2, hstepB = (size_t)HALF * C::LDB * 2;
    const unsigned ldsw = (unsigned)wid * 1024u;
    const int aoff = lds_byte(wr * 64 + fr, fq * 8), boff = lds_byte(wc * 32 + fr, fq * 8);
#define PG8_SA(b, h) (((b) * 2 + (h)) * HTB)
#define PG8_SB(b, h) ((4 + (b) * 2 + (h)) * HTB)
#define PG8_STAGE(bufoff, gbase, voff) do { _Pragma("unroll") for (int _i = 0; _i < 2; ++_i) \
        __builtin_amdgcn_global_load_lds((const unsigned*)((const char*)(gbase) + (voff)[_i]), (LAS unsigned*)(lds + (bufoff) + ldsw + _i * 8192), 16, 0, 0); } while (0)
#define PG8_LDA(dst, b, h) do { _Pragma("unroll") for (int m = 0; m < 4; ++m) _Pragma("unroll") for (int k = 0; k < 2; ++k) dst[m][k] = *(const LAS bf16x8*)(lds + PG8_SA(b, h) + aoff + m * 2048 + k * 1024); } while (0)
#define PG8_LDB(dst, b, h) do { _Pragma("unroll") for (int n = 0; n < 2; ++n) _Pragma("unroll") for (int k = 0; k < 2; ++k) dst[n][k] = *(const LAS bf16x8*)(lds + PG8_SB(b, h) + boff + n * 2048 + k * 1024); } while (0)
#define PG8_MMA(ai, bj, At, Bt) do { __builtin_amdgcn_s_setprio(1); _Pragma("unroll") for (int m = 0; m < 4; ++m) _Pragma("unroll") for (int n = 0; n < 2; ++n) _Pragma("unroll") for (int k = 0; k < 2; ++k) \
        acc[ai][bj][m][n] = __builtin_amdgcn_mfma_f32_16x16x32_bf16(Bt[n][k], At[m][k], acc[ai][bj][m][n], 0, 0, 0); __builtin_amdgcn_s_setprio(0); } while (0)
#define PG8_WAIT_V(n) asm volatile("s_waitcnt vmcnt(" #n ")" ::: "memory")
#define PG8_WAIT_L(n) asm volatile("s_waitcnt lgkmcnt(" #n ")" ::: "memory")
#define PG8_BAR __builtin_amdgcn_s_barrier()
#define PG8_SCHED __builtin_amdgcn_sched_barrier(0)
    Unit cur, nxt; int ui = 0;
    if (!S.next(0, cur)) return;
    f32x4 acc[2][2][4][2];
#pragma unroll
    for (int a = 0; a < 2; ++a)
#pragma unroll
        for (int b = 0; b < 2; ++b)
#pragma unroll
            for (int m = 0; m < 4; ++m)
#pragma unroll
                for (int n = 0; n < 2; ++n) acc[a][b][m][n] = (f32x4){0.f, 0.f, 0.f, 0.f};
    bf16x8 At[4][2], B0[2][2], B1[2][2];
    const char* cA = unitA<C>(g, cur); const char* cB = unitB<C>(g, cur);
    PG8_STAGE(PG8_SB(0, 0), cB, voffB); PG8_STAGE(PG8_SB(0, 1), cB + hstepB, voffB); PG8_STAGE(PG8_SA(0, 0), cA, voffA); PG8_STAGE(PG8_SA(0, 1), cA + hstepA, voffA);
    if (wr == 1) PG8_BAR;
    PG8_WAIT_V(2); PG8_BAR;
    PG8_STAGE(PG8_SB(1, 0), cB + kstep, voffB); PG8_STAGE(PG8_SA(1, 0), cA + kstep, voffA); PG8_STAGE(PG8_SB(1, 1), cB + hstepB + kstep, voffB);
    PG8_WAIT_V(6); PG8_BAR;
    for (;;) {
        const bool has_next = S.next(ui + 1, nxt);
        const char* nA = has_next ? unitA<C>(g, nxt) : cA; const char* nB = has_next ? unitB<C>(g, nxt) : cB;
#define PG8_KBODY(U0, U1) { \
            const bool last = (t == nt - 2); \
            const char* a1 = cA + (size_t)(t + 1) * kstep; \
            const char* a2 = last ? nA : cA + (size_t)(t + 2) * kstep; const char* b2 = last ? nB : cB + (size_t)(t + 2) * kstep; \
            const char* a3 = a2 + kstep; const char* b3 = b2 + kstep; \
            if (U0) PG8_LDB(B0, 0, 0); if (U1) PG8_LDB(B1, 0, 1); PG8_SCHED; PG8_LDA(At, 0, 0); PG8_STAGE(PG8_SA(1, 1), a1 + hstepA, voffA); \
            PG8_WAIT_V(8); PG8_WAIT_L(0); PG8_BAR; if (U0) PG8_MMA(0, 0, At, B0); if (U1) PG8_MMA(0, 1, At, B1); PG8_BAR; PG8_SCHED; \
            PG8_LDA(At, 0, 1); PG8_STAGE(PG8_SB(0, 0), b2, voffB); PG8_STAGE(PG8_SB(0, 1), b2 + hstepB, voffB); PG8_STAGE(PG8_SA(0, 0), a2, voffA); \
            PG8_WAIT_V(8); PG8_WAIT_L(0); PG8_BAR; if (U0) PG8_MMA(1, 0, At, B0); if (U1) PG8_MMA(1, 1, At, B1); PG8_BAR; PG8_SCHED; \
            if (U0) PG8_LDB(B0, 1, 0); if (U1) PG8_LDB(B1, 1, 1); PG8_SCHED; PG8_LDA(At, 1, 0); PG8_STAGE(PG8_SA(0, 1), a2 + hstepA, voffA); \
            PG8_WAIT_V(8); PG8_WAIT_L(0); PG8_BAR; if (U0) PG8_MMA(0, 0, At, B0); if (U1) PG8_MMA(0, 1, At, B1); PG8_BAR; PG8_SCHED; \
            PG8_LDA(At, 1, 1); PG8_STAGE(PG8_SB(1, 0), b3, voffB); PG8_STAGE(PG8_SB(1, 1), b3 + hstepB, voffB); PG8_STAGE(PG8_SA(1, 0), a3, voffA); \
            PG8_WAIT_V(8); PG8_WAIT_L(0); PG8_BAR; if (U0) PG8_MMA(1, 0, At, B0); if (U1) PG8_MMA(1, 1, At, B1); PG8_BAR; PG8_SCHED; }
        if constexpr (C::HK) {
#pragma unroll 1
            for (int t = 0; t < nt / 2; t += 2) PG8_KBODY(true, false)
#pragma unroll 1
            for (int t = nt / 2; t < nt; t += 2) PG8_KBODY(false, true)
        } else {
#pragma unroll 1
            for (int t = 0; t < nt; t += 2) PG8_KBODY(true, true)
        }
#undef PG8_KBODY
        if (wr == 0) PG8_BAR;
        E(acc, cur, wr, wc, fr, fq);
        if (!has_next) break;
#pragma unroll
        for (int a = 0; a < 2; ++a)
#pragma unroll
            for (int b = 0; b < 2; ++b)
#pragma unroll
                for (int m = 0; m < 4; ++m)
#pragma unroll
                    for (int n = 0; n < 2; ++n) acc[a][b][m][n] = (f32x4){0.f, 0.f, 0.f, 0.f};
        cur = nxt; cA = nA; cB = nB; ++ui;
        if (wr == 1) PG8_BAR;
    }
    PG8_WAIT_V(0);
    PG8_BAR;
#undef PG8_SA
#undef PG8_SB
#undef PG8_STAGE
#undef PG8_LDA
#undef PG8_LDB
#undef PG8_MMA
#undef PG8_WAIT_V
#undef PG8_WAIT_L
#undef PG8_BAR
#undef PG8_SCHED
}
}
using pg8::Unit;

#define EPI_LOOP_BEGIN \
    _Pragma("unroll") for (int ai = 0; ai < 2; ++ai) _Pragma("unroll") for (int m = 0; m < 4; ++m) { const int r = u.pm * 256 + ai * 128 + wr * 64 + m * 16 + fr;
#define EPI_LOOP_END asm volatile("" ::: "memory"); }

struct EpiInproj {
    unsigned char* ws;
    DI void operator()(const f32x4 (&acc)[2][2][4][2], const Unit& u, int wr, int wc, int fr, int fq) const {
        const int pn = u.pn; const int mode = (pn >= 15) ? 2 : ((pn == 4 || pn == 8 || pn == 12 || pn == 14) ? 1 : 0);
        if (pn == 31) {
            if (wc == 0 && fq < 2) {
#pragma unroll
                for (int ai = 0; ai < 2; ++ai)
#pragma unroll
                    for (int m = 0; m < 4; ++m) { const int r = u.pm * 256 + ai * 128 + wr * 64 + m * 16 + fr; const float rs = ((const float*)(ws + WS_RSTD))[r]; float* gp = (float*)(ws + WS_G12) + (size_t)r * 12 + 8 * fq;
#pragma unroll
                        for (int e = 0; e < 4; ++e) { gp[e] = sigm(acc[ai][0][m][0][e] * rs); if (fq == 0) gp[4 + e] = sigm(acc[ai][0][m][1][e] * rs); } } }
            return; }
        float rsv[8];
#pragma unroll
        for (int it = 0; it < 8; ++it) rsv[it] = ((const float*)(ws + WS_RSTD))[u.pm * 256 + (it >> 2) * 128 + wr * 64 + (it & 3) * 16 + fr];
#pragma unroll
        for (int ai = 0; ai < 2; ++ai)
#pragma unroll
            for (int m = 0; m < 4; ++m) { const int r = u.pm * 256 + ai * 128 + wr * 64 + m * 16 + fr; const float rs = rsv[ai * 4 + m];
#pragma unroll
            for (int bj = 0; bj < 2; ++bj) { const int c8 = pn * 256 + bj * 128 + wc * 32 + 8 * fq;
                float v[8];
#pragma unroll
                for (int e = 0; e < 4; ++e) { v[e] = acc[ai][bj][m][0][e] * rs; v[4 + e] = acc[ai][bj][m][1][e] * rs; }
                if (mode == 1) {
#pragma unroll
                    for (int e = 0; e < 8; ++e) v[e] = v[e] * sigm(v[e]); }
                if (pn < 15) { u32x4 w; w.x = cvtpk(v[0], v[1]); w.y = cvtpk(v[2], v[3]); w.z = cvtpk(v[4], v[5]); w.w = cvtpk(v[6], v[7]);
                    *(u32x4*)((bf16_t*)(ws + WS_PROJ) + (size_t)r * NP + c8) = w; }
                else { unsigned q0 = 0u, q1 = 0u;
#pragma unroll
                    for (int e = 0; e < 4; ++e) { q0 = __builtin_amdgcn_cvt_pk_u8_f32(sigm(v[e]) * 255.f, e, q0); q1 = __builtin_amdgcn_cvt_pk_u8_f32(sigm(v[4 + e]) * 255.f, e, q1); }
                    *(u32x2*)((unsigned char*)(ws + WS_GATES) + (size_t)r * NGATE + (c8 - NP)) = (u32x2){q0, q1}; } } }
    }
};
struct EpiGlu {
    unsigned char* ws; const float* glub;
    DI void operator()(const f32x4 (&acc)[2][2][4][2], const Unit& u, int wr, int wc, int fr, int fq) const {
        const int col = u.pn * 128 + wc * 32 + 8 * fq;
        EPI_LOOP_BEGIN
            float z[8]; unpack8(*(const u32x4*)((const bf16_t*)(ws + WS_PROJ) + (size_t)r * NP + C_S5Z + col), z);
            float ba[8], bg[8];
#pragma unroll
            for (int e = 0; e < 8; ++e) { ba[e] = glub[col + e]; bg[e] = glub[256 + col + e]; }
            float v[8];
#pragma unroll
            for (int e = 0; e < 8; ++e) { const float a = acc[ai][0][m][e >> 2][e & 3] + ba[e], gg = acc[ai][1][m][e >> 2][e & 3] + bg[e]; v[e] = a * sigm(gg) * z[e]; }
            u32x4 w; w.x = cvtpk(v[0], v[1]); w.y = cvtpk(v[2], v[3]); w.z = cvtpk(v[4], v[5]); w.w = cvtpk(v[6], v[7]);
            *(u32x4*)((bf16_t*)(ws + WS_OUTS) + (size_t)r * DM + 768 + col) = w;
        EPI_LOOP_END
    }
};
DI void unpack_u8(u32x2 w, float (&f)[8]) {
    f[0] = (float)(w.x & 0xffu); f[1] = (float)((w.x >> 8) & 0xffu); f[2] = (float)((w.x >> 16) & 0xffu); f[3] = (float)(w.x >> 24);
    f[4] = (float)(w.y & 0xffu); f[5] = (float)((w.y >> 8) & 0xffu); f[6] = (float)((w.y >> 16) & 0xffu); f[7] = (float)(w.y >> 24);
}
struct EpiBranch {
    unsigned char* ws;
    DI void operator()(const f32x4 (&acc)[2][2][4][2], const Unit& u, int wr, int wc, int fr, int fq) const {
        const int z = u.z; const int cb = u.pn * 128 + wc * 32 + 8 * fq;
        const unsigned char* gbase = (const unsigned char*)(ws + WS_GATES) + (2 * z) * 1024 + cb; bf16_t* tbase = (bf16_t*)(ws + WS_TMP) + cb;
        u32x2 g0 = {0, 0}, g1 = g0, ng0 = g0, ng1 = g0; u32x4 t0 = {0, 0, 0, 0}, nt0 = t0;
        { const size_t r = (size_t)(u.pm * 256 + wr * 64 + fr); g0 = *(const u32x2*)(gbase + r * NGATE); g1 = *(const u32x2*)(gbase + r * NGATE + 1024);
          if (z > 0) t0 = *(const u32x4*)(tbase + r * DM); }
#pragma unroll
        for (int it = 0; it < 8; ++it) { const int ai = it >> 2, m = it & 3; const size_t r = (size_t)(u.pm * 256 + ai * 128 + wr * 64 + m * 16 + fr);
            if (it < 7) { const size_t rn = (size_t)(u.pm * 256 + ((it + 1) >> 2) * 128 + wr * 64 + ((it + 1) & 3) * 16 + fr);
                ng0 = *(const u32x2*)(gbase + rn * NGATE); ng1 = *(const u32x2*)(gbase + rn * NGATE + 1024);
                if (z > 0) nt0 = *(const u32x4*)(tbase + rn * DM); }
            asm volatile("" ::: "memory");
            { float ga[8], gb[8], t8[8], v[8]; unpack_u8(g0, ga); unpack_u8(g1, gb); unpack8(t0, t8);
#pragma unroll
              for (int e = 0; e < 8; ++e) { v[e] = (acc[ai][0][m][e >> 2][e & 3] * ga[e] + acc[ai][1][m][e >> 2][e & 3] * gb[e]) * (1.f / 255.f); if (z > 0) v[e] += t8[e]; }
              u32x4 w; w.x = cvtpk(v[0], v[1]); w.y = cvtpk(v[2], v[3]); w.z = cvtpk(v[4], v[5]); w.w = cvtpk(v[6], v[7]);
              if (z == 0) *(u32x4*)(tbase + r * DM) = w; else *(u32x4*)((bf16_t*)(ws + WS_MIXED) + r * DM + cb) = w; }
            g0 = ng0; g1 = ng1; t0 = nt0;
            asm volatile("" ::: "memory"); }
    }
};
struct EpiOut {
    const float* xin; float* xout;
    DI void operator()(const f32x4 (&acc)[2][2][4][2], const Unit& u, int wr, int wc, int fr, int fq) const {
        const int cb = u.pn * 256 + wc * 32 + 8 * fq;
        f32x4 x[4], nx[4];
        { const size_t off = (size_t)(u.pm * 256 + wr * 64 + fr) * DM + cb; x[0] = *(const f32x4*)(xin + off); x[1] = *(const f32x4*)(xin + off + 4); x[2] = *(const f32x4*)(xin + off + 128); x[3] = *(const f32x4*)(xin + off + 132); }
#pragma unroll
        for (int it = 0; it < 8; ++it) { const int ai = it >> 2, m = it & 3; const size_t off = (size_t)(u.pm * 256 + ai * 128 + wr * 64 + m * 16 + fr) * DM + cb;
            if (it < 7) { const size_t on = (size_t)(u.pm * 256 + ((it + 1) >> 2) * 128 + wr * 64 + ((it + 1) & 3) * 16 + fr) * DM + cb;
                nx[0] = *(const f32x4*)(xin + on); nx[1] = *(const f32x4*)(xin + on + 4); nx[2] = *(const f32x4*)(xin + on + 128); nx[3] = *(const f32x4*)(xin + on + 132); }
            asm volatile("" ::: "memory");
            *(f32x4*)(xout + off) = x[0] + acc[ai][0][m][0]; *(f32x4*)(xout + off + 4) = x[1] + acc[ai][0][m][1];
            *(f32x4*)(xout + off + 128) = x[2] + acc[ai][1][m][0]; *(f32x4*)(xout + off + 132) = x[3] + acc[ai][1][m][1];
#pragma unroll
            for (int q = 0; q < 4; ++q) x[q] = nx[q];
            asm volatile("" ::: "memory"); }
    }
};
struct EpiS5a {
    unsigned char* ws;
    DI void operator()(const f32x4 (&acc)[2][2][4][2], const Unit& u, int wr, int wc, int fr, int fq) const {
        EPI_LOOP_BEGIN
            const int c8 = wc * 32 + 8 * fq;
            float* p = (float*)(ws + WS_STL) + ((size_t)u.z * 256 + r) * 128 + c8;
            *(f32x4*)p = acc[ai][0][m][0]; *(f32x4*)(p + 4) = acc[ai][0][m][1];
        EPI_LOOP_END
    }
};
struct EpiS5b {
    unsigned char* ws;
    DI void operator()(const f32x4 (&acc)[2][2][4][2], const Unit& u, int wr, int wc, int fr, int fq) const {
        EPI_LOOP_BEGIN
            const int b = r >> 6, ch = r & 63;
#pragma unroll
            for (int bj = 0; bj < 2; ++bj) { const int col = u.pn * 256 + bj * 128 + wc * 32 + 8 * fq; const int t = col >> 4, c = col & 15;
                const size_t tok = (size_t)b * S + ch * 64 + t;
                u32x4 w; w.x = cvtpk(acc[ai][bj][m][0][0], acc[ai][bj][m][0][1]); w.y = cvtpk(acc[ai][bj][m][0][2], acc[ai][bj][m][0][3]);
                w.z = cvtpk(acc[ai][bj][m][1][0], acc[ai][bj][m][1][1]); w.w = cvtpk(acc[ai][bj][m][1][2], acc[ai][bj][m][1][3]);
                *(u32x4*)((bf16_t*)(ws + WS_Y5) + tok * 256 + u.z * 16 + c) = w; }
        EPI_LOOP_END
    }
};


#define XB_TMO      128
#define XB_XCNT(j)  (256  + 64 * (j))
#define XB_XSUB(j)  (1280 + 64 * (j))
#define XB_XGEN(j)  (2304 + 64 * (j))
#define XB_TOP      3328
#define XB_TOPGEN   3392
#define XCD_BAR_WORDS 3456
#define XB_SPIN_CAP (1u << 20)
DI unsigned xb_ld(unsigned* p)              { return __hip_atomic_load(p, __ATOMIC_RELAXED, __HIP_MEMORY_SCOPE_AGENT); }
DI unsigned xb_add(unsigned* p, unsigned v) { return __hip_atomic_fetch_add(p, v, __ATOMIC_RELAXED, __HIP_MEMORY_SCOPE_AGENT); }
DI unsigned xb_xcc_id() { return (unsigned)__builtin_amdgcn_s_getreg((3 << 11) | 20) & 0xFu; }
#define XB_SPIN(cond, bar) do { unsigned _sp = 0; while (cond) { __builtin_amdgcn_s_sleep(1); \
    if ((++_sp & 255u) == 0u) { if (xb_ld(&(bar)[XB_TMO])) break; if (_sp > XB_SPIN_CAP) { atomicAdd(&(bar)[XB_TMO], 1u); break; } } } } while (0)
struct XcdBarrier { unsigned* bar; unsigned x; volatile LAS unsigned* st; };
DI XcdBarrier xcd_barrier_post(unsigned* bar, volatile LAS unsigned* st) {
    XcdBarrier b; b.bar = bar; b.x = xb_xcc_id(); b.st = st;
    if (threadIdx.x == 0) (void)xb_add(&bar[XB_XCNT(b.x)], 1u);
    return b;
}
DI void xcd_barrier_complete(unsigned* bar, unsigned x, unsigned& nloc, unsigned& nx) {
    const unsigned G = gridDim.x * gridDim.y * gridDim.z;
    unsigned sum, cnt, mine, sp = 0u;
    for (;;) {
        sum = 0u; cnt = 0u; mine = 0u;
#pragma unroll
        for (unsigned j = 0; j < 16; ++j) { const unsigned c = xb_ld(&bar[XB_XCNT(j)]); sum += c; cnt += (c > 0u) ? 1u : 0u; mine = (j == x) ? c : mine; }
        if (sum == G) break;
        __builtin_amdgcn_s_sleep(1);
        if ((++sp & 255u) == 0u) { if (xb_ld(&bar[XB_TMO])) break; if (sp > XB_SPIN_CAP) { atomicAdd(&bar[XB_TMO], 1u); break; } }
    }
    nloc = mine > 0u ? mine : 1u; nx = cnt > 0u ? cnt : 1u;
}
DI void xcd_barrier(const XcdBarrier& b) {
    asm volatile("s_waitcnt vmcnt(0)" ::: "memory");
    __syncthreads();
    if (threadIdx.x == 0) {
        unsigned* bar = b.bar;
        __builtin_amdgcn_s_waitcnt(0);
        unsigned nloc = b.st[0], nx = b.st[1];
        if (nloc == 0u) { xcd_barrier_complete(bar, b.x, nloc, nx); b.st[0] = nloc; b.st[1] = nx; }
        const unsigned old = xb_add(&bar[XB_XSUB(b.x)], 1u);
        const unsigned gen = old / nloc;
        if (old + 1u == (gen + 1u) * nloc) {
            __builtin_amdgcn_fence(__ATOMIC_RELEASE, "agent");
            asm volatile("s_waitcnt vmcnt(0)" ::: "memory");
            const unsigned og = xb_add(&bar[XB_TOP], 1u);
            const unsigned tg = og / nx;
            if (og + 1u == (tg + 1u) * nx) xb_add(&bar[XB_TOPGEN], 1u);
            else XB_SPIN(xb_ld(&bar[XB_TOPGEN]) == tg, bar);
            __builtin_amdgcn_fence(__ATOMIC_ACQUIRE, "agent");
            xb_add(&bar[XB_XGEN(b.x)], 1u);
            asm volatile("s_waitcnt vmcnt(0)" ::: "memory");
        } else {
            XB_SPIN(xb_ld(&bar[XB_XGEN(b.x)]) == gen, bar);
            __builtin_amdgcn_fence(__ATOMIC_ACQUIRE, "agent");
            asm volatile("s_waitcnt vmcnt(0)" ::: "memory");
        }
    }
    __syncthreads();
}

DI void cnt_barrier(unsigned* ctr, unsigned target) {
    asm volatile("s_waitcnt vmcnt(0)" ::: "memory");
    __syncthreads();
    if (threadIdx.x == 0) {
        __builtin_amdgcn_fence(__ATOMIC_RELEASE, "agent"); asm volatile("s_waitcnt vmcnt(0)" ::: "memory");
        __hip_atomic_fetch_add(ctr, 1u, __ATOMIC_RELAXED, __HIP_MEMORY_SCOPE_AGENT);
        unsigned sp = 0;
        while (__hip_atomic_load(ctr, __ATOMIC_RELAXED, __HIP_MEMORY_SCOPE_AGENT) < target) { __builtin_amdgcn_s_sleep(1); if (++sp > (1u << 24)) break; }
        __builtin_amdgcn_fence(__ATOMIC_ACQUIRE, "agent"); asm volatile("s_waitcnt vmcnt(0)" ::: "memory");
    }
    __syncthreads();
}
constexpr int CW_BAR = 16384, CW_FLAG = 32768;
constexpr int MISC_OFF = 131072 + 320;
struct Args { const float* in[21]; float* out; unsigned char* ws; };
struct Ctx {
    LAS unsigned char* lds; int tid, lane, wave, G, gw, NGW; long gtid, GT;
    unsigned char* ws;
};

DI Ctx mkctx(unsigned char* ws, LAS unsigned char* lds) {
    Ctx F; int tid = threadIdx.x; asm volatile("" : "+v"(tid));
    F.lds = lds; F.tid = tid; F.lane = tid & 63; F.wave = __builtin_amdgcn_readfirstlane(tid >> 6);
    F.G = gridDim.x; F.gw = blockIdx.x * NWAVES + F.wave; F.NGW = F.G * NWAVES; F.gtid = (long)blockIdx.x * NTHR + tid; F.GT = (long)F.G * NTHR; F.ws = ws; return F;
}
DI void transpose_item(const float* W, int ldw, int srccol0, const float* kscale, bf16_t* WT, int ldwt, int dstrow0, int k0, LAS float* scr, int lane, int nvalid = 32) {
#pragma unroll 8
    for (int i = 0; i < 32; ++i) { const int kk = 2 * i + (lane >> 5); float v = (lane & 31) < nvalid ? W[(size_t)(k0 + kk) * ldw + srccol0 + (lane & 31)] : 0.f; if (kscale) v *= kscale[k0 + kk]; scr[kk * 33 + (lane & 31)] = v; }
    LDS_WAIT();
    const int c = lane & 7;
#pragma unroll
    for (int j = 0; j < 4; ++j) { const int n = (lane >> 3) + 8 * j; const LAS float* s = scr + (8 * c) * 33 + n;
        u32x4 o; o.x = cvtpk(s[0 * 33], s[1 * 33]); o.y = cvtpk(s[2 * 33], s[3 * 33]); o.z = cvtpk(s[4 * 33], s[5 * 33]); o.w = cvtpk(s[6 * 33], s[7 * 33]);
        *(u32x4*)(WT + (size_t)(dstrow0 + n) * ldwt + k0 + 8 * c) = o; }
    LDS_WAIT();
}
DI void k1_prologue(const Ctx& F, const Args& a) {
    LAS float* scr = (LAS float*)(F.lds + F.wave * 16384);
    unsigned char* ws = F.ws;
    constexpr int I_WIN = 16 * 256, I_WB = 128, I_WOUT = 512, I_GLU = 64, I_CW1 = 64;
    constexpr int N_WIN = 2 * I_WIN, N_WB = 8 * I_WB, N_WOUT = 2 * I_WOUT, N_GLU = 2 * I_GLU, N_CW1 = 4 * I_CW1;
    for (int it = F.gw; it < N_WIN + N_WB + N_WOUT + N_GLU + N_CW1; it += F.NGW) {
        int r = it;
        if (r < N_WIN) { const int l = r / I_WIN; r %= I_WIN; const int kb = r / 256, nb = r % 256, n0 = nb * 32;
            const int src = n0 < 1024 ? n0 : (n0 < NIN ? n0 + 12 : 1024), nv = n0 < NIN ? 32 : (n0 == NIN ? 12 : 0);
            transpose_item(a.in[3] + (size_t)l * DM * NINW, NINW, src, a.in[2] + l * DM, (bf16_t*)(ws + WS_WINT) + (size_t)l * NINP * DM, DM, n0, kb * 64, scr, F.lane, nv); continue; }
        r -= N_WIN;
        if (r < N_WB) { const int lm = r / I_WB; r %= I_WB; const int kb = r / 32, nb = r % 32, m = lm & 3, l = lm >> 2;
            transpose_item(a.in[19] + (size_t)lm * 256 * DM, DM, nb * 32, nullptr, (bf16_t*)(ws + WS_WB2T) + ((size_t)(l * 2 + (m >> 1)) * 8 + (nb >> 2)) * (256 * 512) + (m & 1) * 256, 512, (m & 1) * 128 + (nb & 3) * 32, kb * 64, scr, F.lane); continue; }
        r -= N_WB;
        if (r < N_WOUT) { const int l = r / I_WOUT; r %= I_WOUT; const int kb = r / 32, nb = r % 32;
            transpose_item(a.in[20] + (size_t)l * DM * DM, DM, nb * 32, nullptr, (bf16_t*)(ws + WS_WOUTT) + (size_t)l * DM * DM, DM, nb * 32, kb * 64, scr, F.lane); continue; }
        r -= N_WOUT;
        if (r < N_GLU) { const int l = r / I_GLU; r %= I_GLU; const int kb = r / 16, nb = r % 16, n0 = nb * 32; const int pn = n0 >> 8, bj = (n0 >> 7) & 1, lc = n0 & 127;
            transpose_item(a.in[17] + (size_t)l * 256 * 512, 512, bj * 256 + pn * 128 + lc, nullptr, (bf16_t*)(ws + WS_GLUT) + (size_t)l * 512 * 256, 256, n0, kb * 64, scr, F.lane); continue; }
        r -= N_GLU;
        { const int lj = r / I_CW1; r %= I_CW1; const int kb = r / 2, nb = r % 2;
            transpose_item(a.in[6] + (size_t)lj * 2048 * 64, 64, nb * 32, nullptr, (bf16_t*)(ws + WS_CW1T) + (size_t)lj * 64 * 2048, 2048, nb * 32, kb * 64, scr, F.lane); }
    }
    for (long i = F.gtid; i < 2 * 2 * 8 * 256 * 32; i += F.GT) { const int q16 = (int)(i & 31), row = (int)((i >> 5) & 255); const long blk = i >> 13;
        *(u32x4*)((bf16_t*)(ws + WS_WB2T) + (size_t)blk * (256 * 512) + (size_t)row * 512 + (row < 128 ? 256 : 0) + q16 * 8) = (u32x4){0u, 0u, 0u, 0u}; }
    float* bias1 = (float*)(ws + WS_CTL + 32768);
    for (long i = F.gtid; i < 4 * 64 * 16; i += F.GT) { const int o = (int)(i & 63), kc = (int)((i >> 6) & 15), lj = (int)(i >> 10); float s = 0.f;
        for (int k = kc * 128; k < kc * 128 + 128; ++k) s += a.in[5][lj * 2048 + k] * a.in[6][((size_t)lj * 2048 + k) * 64 + o];
        bias1[(lj * 16 + kc) * 64 + o] = s; }
    f32x2* pw = (f32x2*)(ws + WS_POW);
    for (long i = F.gtid; i < 2 * 16 * 64 * 65; i += F.GT) { const int k = (int)(i % 65), p = (int)((i / 65) % 64), lg = (int)(i / (65 * 64));
        const float dt = __expf(a.in[11][lg]), lr = a.in[9][lg * 64 + p], li = a.in[10][lg * 64 + p];
        const float mag = __expf(lr * dt * (float)k); float sn, cs; sincos_acc(li * dt * (float)k, sn, cs); pw[i] = (f32x2){mag * cs, mag * sn}; }
    f32x2* bb = (f32x2*)(ws + WS_BBAR);
    for (long i = F.gtid; i < 2 * 16 * 64 * 16; i += F.GT) { const int c = (int)(i & 15), p = (int)((i >> 4) & 63), lg = (int)(i >> 10);
        const float dt = __expf(a.in[11][lg]), lr = a.in[9][lg * 64 + p], li = a.in[10][lg * 64 + p];
        const float mag = __expf(lr * dt); float sn, cs; sincos_acc(li * dt, sn, cs); const float abr = mag * cs, abi = mag * sn, den = lr * lr + li * li;
        const float cr = ((abr - 1.f) * lr + abi * li) / den, ci = (abi * lr - (abr - 1.f) * li) / den;
        const float br = a.in[12][((size_t)lg * 64 + p) * 16 + c], bi = a.in[13][((size_t)lg * 64 + p) * 16 + c];
        bb[i] = (f32x2){cr * br - ci * bi, cr * bi + ci * br}; }
}
DI void kmat_build(const Ctx& F, const Args& a) {
    const f32x2* pw = (const f32x2*)(F.ws + WS_POW); const f32x2* bb = (const f32x2*)(F.ws + WS_BBAR); float* km = (float*)(F.ws + WS_KMAT);
    for (long i = F.gtid; i < 2 * 16 * 64 * 256; i += F.GT) { const int cc = (int)(i & 15), c = (int)((i >> 4) & 15), k = (int)((i >> 8) & 63), lg = (int)(i >> 14); float s = 0.f;
        for (int p = 0; p < 64; ++p) { const float cr = a.in[14][((size_t)lg * 16 + c) * 64 + p], ci = a.in[15][((size_t)lg * 16 + c) * 64 + p];
            const f32x2 w = pw[((size_t)lg * 64 + p) * 65 + k], b = bb[((size_t)lg * 64 + p) * 16 + cc];
            const float xr = cr * w.x - ci * w.y, xi = cr * w.y + ci * w.x; s += xr * b.x - xi * b.y; }
        if (k == 0 && c == cc) s += a.in[16][lg * 16 + c];
        km[i] = s; }
}
DI void s5_expand(const Ctx& F, const Args& a, int l) {
    const f32x2* pw = (const f32x2*)(F.ws + WS_POW); const f32x2* bb = (const f32x2*)(F.ws + WS_BBAR); const float* km = (const float*)(F.ws + WS_KMAT);
    bf16_t* spg = (bf16_t*)(F.ws + WS_SPG); bf16_t* sa2 = (bf16_t*)(F.ws + WS_SA2);
    for (long i = F.gtid; i < 16 * 256 * 64; i += F.GT) { const int tt = (int)(i & 63), comp = (int)((i >> 6) & 255), g = (int)(i >> 14), lg = l * 16 + g;
        float v[16];
        if (comp < 128) { const int p = comp & 63; const f32x2 w = pw[((size_t)lg * 64 + p) * 65 + 63 - tt];
#pragma unroll
            for (int c = 0; c < 16; ++c) { const f32x2 b = bb[((size_t)lg * 64 + p) * 16 + c]; v[c] = comp < 64 ? (w.x * b.x - w.y * b.y) : (w.x * b.y + w.y * b.x); } }
        else {
#pragma unroll
            for (int c = 0; c < 16; ++c) v[c] = 0.f; }
        u32x4 o0, o1; o0.x = cvtpk(v[0], v[1]); o0.y = cvtpk(v[2], v[3]); o0.z = cvtpk(v[4], v[5]); o0.w = cvtpk(v[6], v[7]);
        o1.x = cvtpk(v[8], v[9]); o1.y = cvtpk(v[10], v[11]); o1.z = cvtpk(v[12], v[13]); o1.w = cvtpk(v[14], v[15]);
        bf16_t* d = spg + ((size_t)g * 256 + comp) * 1024 + tt * 16; *(u32x4*)d = o0; *(u32x4*)(d + 8) = o1; }
    for (long i = F.gtid; i < 16 * 64 * 16 * 64; i += F.GT) { const int tt = (int)(i & 63), c = (int)((i >> 6) & 15), t = (int)((i >> 10) & 63), g = (int)(i >> 16), lg = l * 16 + g;
        float v[16];
        if (t >= tt) { const float* s = km + (((size_t)lg * 64 + (t - tt)) * 16 + c) * 16;
#pragma unroll
            for (int e = 0; e < 16; ++e) v[e] = s[e]; }
        else {
#pragma unroll
            for (int e = 0; e < 16; ++e) v[e] = 0.f; }
        u32x4 o0, o1; o0.x = cvtpk(v[0], v[1]); o0.y = cvtpk(v[2], v[3]); o0.z = cvtpk(v[4], v[5]); o0.w = cvtpk(v[6], v[7]);
        o1.x = cvtpk(v[8], v[9]); o1.y = cvtpk(v[10], v[11]); o1.z = cvtpk(v[12], v[13]); o1.w = cvtpk(v[14], v[15]);
        bf16_t* d = sa2 + ((size_t)g * 1024 + t * 16 + c) * 1152 + tt * 16; *(u32x4*)d = o0; *(u32x4*)(d + 8) = o1; }
    for (long i = F.gtid; i < 16 * 64 * 16 * 16; i += F.GT) { const int c8 = (int)(i & 15), c = (int)((i >> 4) & 15), t = (int)((i >> 8) & 63), g = (int)(i >> 14), lg = l * 16 + g;
        float v[8];
#pragma unroll
        for (int e = 0; e < 8; ++e) { const int comp = c8 * 8 + e, p = comp & 63; const f32x2 w = pw[((size_t)lg * 64 + p) * 65 + t + 1];
            const float cr = a.in[14][((size_t)lg * 16 + c) * 64 + p], ci = a.in[15][((size_t)lg * 16 + c) * 64 + p];
            v[e] = comp < 64 ? (cr * w.x - ci * w.y) : -(cr * w.y + ci * w.x); }
        u32x4 o; o.x = cvtpk(v[0], v[1]); o.y = cvtpk(v[2], v[3]); o.z = cvtpk(v[4], v[5]); o.w = cvtpk(v[6], v[7]);
        *(u32x4*)(sa2 + ((size_t)g * 1024 + t * 16 + c) * 1152 + 1024 + c8 * 8) = o; }
}

DI void p1_pre(const Ctx& F, const float* xin, int l) {
    bf16_t* xb = (bf16_t*)(F.ws + WS_XB); float* rstd = (float*)(F.ws + WS_RSTD);
    for (int tok0 = F.gw; tok0 < TH; tok0 += 2 * F.NGW) {
        const int tok1 = tok0 + F.NGW < TH ? tok0 + F.NGW : tok0;
        const f32x4* xr0 = (const f32x4*)(xin + (size_t)tok0 * DM) + F.lane; const f32x4* xr1 = (const f32x4*)(xin + (size_t)tok1 * DM) + F.lane;
        f32x4 v0[4], v1[4]; float s0 = 0.f, s1 = 0.f;
#pragma unroll
        for (int j = 0; j < 4; ++j) { v0[j] = xr0[64 * j]; v1[j] = xr1[64 * j]; }
#pragma unroll
        for (int j = 0; j < 4; ++j) { s0 += (v0[j].x * v0[j].x + v0[j].y * v0[j].y) + (v0[j].z * v0[j].z + v0[j].w * v0[j].w); s1 += (v1[j].x * v1[j].x + v1[j].y * v1[j].y) + (v1[j].z * v1[j].z + v1[j].w * v1[j].w); }
        const float r0 = __builtin_amdgcn_rsqf(wave_sum(s0) * (1.f / DM) + EPS), r1 = __builtin_amdgcn_rsqf(wave_sum(s1) * (1.f / DM) + EPS);
        u32x2* o0 = (u32x2*)(xb + (size_t)tok0 * DM) + F.lane; u32x2* o1 = (u32x2*)(xb + (size_t)tok1 * DM) + F.lane;
#pragma unroll
        for (int j = 0; j < 4; ++j) { o0[64 * j] = (u32x2){cvtpk(v0[j].x, v0[j].y), cvtpk(v0[j].z, v0[j].w)}; o1[64 * j] = (u32x2){cvtpk(v1[j].x, v1[j].y), cvtpk(v1[j].z, v1[j].w)}; }
        if (F.lane == 0) { rstd[tok0] = r0; rstd[tok1] = r1; }
    }
}

#define DPPF(v, ctrl) __builtin_bit_cast(float, __builtin_amdgcn_update_dpp(0, __builtin_bit_cast(int, (v)), (ctrl), 0xF, 0xF, true))
DI void p3_qk(const Ctx& F, const Args& a, int l, int half) {
    const bf16_t* proj = (const bf16_t*)(F.ws + WS_PROJ); bf16_t* qn = (bf16_t*)(F.ws + WS_QN); bf16_t* ks = (bf16_t*)(F.ws + WS_KS); bf16_t* kw = (bf16_t*)(F.ws + WS_KW);
    const int* pos = (const int*)a.in[1]; const float* qkg = a.in[4] + l * 256; const int lane = F.lane, sub = lane >> 4, d0 = (lane & 15) * 4;
    float invf[4], g0[4], g2[4], g3[4];
#pragma unroll
    for (int e = 0; e < 4; ++e) { invf[e] = ex2(-(float)((d0 + e) & 31) * (13.287712379549449f / 32.f)); g0[e] = qkg[d0 + e]; g2[e] = qkg[128 + d0 + e]; g3[e] = qkg[192 + d0 + e]; }
    for (int t4 = F.gw; t4 < TH / 4; t4 += F.NGW) { const int tok = t4 * 4 + sub, b = tok >> 12, s = tok & 4095;
        const bf16_t* pr = proj + (size_t)tok * NP + d0;
        u32x2 raw[8];
#pragma unroll
        for (int vv = 0; vv < 8; ++vv) { const int col = vv < 4 ? C_NQ + vv * 64 : (vv < 6 ? C_NKV + 256 + (vv - 4) * 64 : C_NKV + 512 + (vv - 6) * 64); raw[vv] = *(const u32x2*)(pr + col); }
        const float pf = (float)pos[(half * NBH + b) * S + s]; float sn[4], cs[4];
#pragma unroll
        for (int e = 0; e < 4; ++e) sincos_acc(pf * invf[e], sn[e], cs[e]);
        const size_t fo = (size_t)(s >> 6) * 4096 + ((((s >> 5) & 1) * 4 + (d0 >> 4)) * 64 + ((d0 >> 3) & 1) * 32 + (s & 31)) * 8 + (d0 & 7);
#pragma unroll
        for (int vv = 0; vv < 8; ++vv) { float x[4]; unpack4(raw[vv], x);
            float ss = (x[0] * x[0] + x[1] * x[1]) + (x[2] * x[2] + x[3] * x[3]);
            ss += DPPF(ss, 0xB1); ss += DPPF(ss, 0x4E); ss += DPPF(ss, 0x124); ss += DPPF(ss, 0x128);
            const float rs = __builtin_amdgcn_rsqf(ss * (1.f / 64.f) + EPS); float r[4];
#pragma unroll
            for (int e = 0; e < 4; ++e) { const float y = x[e] * rs * (vv < 4 ? g0[e] : (vv < 6 ? g2[e] : g3[e])); const float o = DPPF(y, 0x128);
                r[e] = d0 < 32 ? y * cs[e] - o * sn[e] : y * cs[e] + o * sn[e]; }
            if (vv < 4) *(u32x2*)(qn + (size_t)tok * 256 + vv * 64 + d0) = (u32x2){cvtpk(r[0] * (0.125f * LOG2E), r[1] * (0.125f * LOG2E)), cvtpk(r[2] * (0.125f * LOG2E), r[3] * (0.125f * LOG2E))};
            else { bf16_t* kd = (vv < 6 ? ks + ((size_t)b * 2 + (vv - 4)) * S * 64 : kw + ((size_t)b * 2 + (vv - 6)) * S * 64) + fo; *(u32x2*)kd = (u32x2){cvtpk(r[0], r[1]), cvtpk(r[2], r[3])}; }
        }
    }
}
DI void p3_vt(const Ctx& F) {
    const bf16_t* __restrict__ proj = (const bf16_t*)(F.ws + WS_PROJ);
#pragma unroll 2
    for (long i = F.gtid; i < (long)NBH * 8 * 512 * 64; i += F.GT) { const int d = (int)(i & 63), t8 = (int)((i >> 6) & 511), hv = (int)((i >> 15) & 7), b = (int)(i >> 18);
        const int col = hv < 2 ? C_NKV + 256 + 128 + hv * 64 : (hv < 4 ? C_NKV + 512 + 128 + (hv - 2) * 64 : C_SB + 512 + (hv - 4) * 64);
        const bf16_t* src = proj + ((size_t)b * S + t8 * 8) * NP + col + d;
        unsigned short e[8];
#pragma unroll
        for (int j = 0; j < 8; ++j) e[j] = src[(size_t)j * NP];
        bf16_t* base = hv < 2 ? (bf16_t*)(F.ws + WS_VTS) + ((size_t)b * 2 + hv) * 64 * S : (hv < 4 ? (bf16_t*)(F.ws + WS_VTW) + ((size_t)b * 2 + hv - 2) * 64 * S : (bf16_t*)(F.ws + WS_VTB) + ((size_t)b * 4 + hv - 4) * 64 * S);
        bf16_t* dst = base + (size_t)(t8 >> 3) * 4096 + (((((t8 >> 2) & 1) * 2 + ((t8 >> 1) & 1)) * 2 + (d >> 5)) * 64 + (d & 31)) * 8 + (t8 & 1) * 4;
        *(u32x2*)dst = (u32x2){e[0] | ((unsigned)e[1] << 16), e[2] | ((unsigned)e[3] << 16)};
        *(u32x2*)(dst + 32 * 8) = (u32x2){e[4] | ((unsigned)e[5] << 16), e[6] | ((unsigned)e[7] << 16)}; }
#pragma unroll 4
    for (long i = F.gtid; i < (long)NBH * 4 * S * 8; i += F.GT) { const int d8 = (int)(i & 7), t = (int)((i >> 3) & 4095), hq = (int)((i >> 15) & 3), b = (int)(i >> 17);
        u32x4 v = *(const u32x4*)(proj + ((size_t)b * S + t) * NP + C_SB + 256 + hq * 64 + d8 * 8);
        { float f[8]; unpack8(v, f); v.x = cvtpk(f[0] * (0.125f * LOG2E), f[1] * (0.125f * LOG2E)); v.y = cvtpk(f[2] * (0.125f * LOG2E), f[3] * (0.125f * LOG2E)); v.z = cvtpk(f[4] * (0.125f * LOG2E), f[5] * (0.125f * LOG2E)); v.w = cvtpk(f[6] * (0.125f * LOG2E), f[7] * (0.125f * LOG2E)); }
        bf16_t* dst = (bf16_t*)(F.ws + WS_KB) + ((size_t)b * 4 + hq) * S * 64 + (size_t)(t >> 6) * 4096 + ((((t >> 5) & 1) * 4 + (d8 >> 1)) * 64 + (d8 & 1) * 32 + (t & 31)) * 8;
        *(u32x4*)dst = v; }
}
DI void p3_conv_relayout(const Ctx& F, const Args& a, int l) {
    const bf16_t* __restrict__ proj = (const bf16_t*)(F.ws + WS_PROJ); bf16_t* __restrict__ outs = (bf16_t*)(F.ws + WS_OUTS); bf16_t* __restrict__ ux = (bf16_t*)(F.ws + WS_UX);
    const float* __restrict__ cw = a.in[8] + l * 768;
#pragma unroll 1
    for (long i = F.gtid; i < (long)TH * 32; i += F.GT) { const int c0 = (int)(i & 31) * 8; const int tok = (int)(i >> 5), s = tok & 4095;
        const bf16_t* pr = proj + (size_t)tok * NP + C_SC + c0;
        float bg[8], u0[8], u1[8], u2[8], xi[8], z[8];
        unpack8(*(const u32x4*)pr, bg); unpack8(*(const u32x4*)(pr + 256), u2); unpack8(*(const u32x4*)(pr + 512), xi); unpack8(*(const u32x4*)(pr + (C_SCZ - C_SC)), z);
#pragma unroll
        for (int e = 0; e < 8; ++e) { u2[e] *= xi[e]; u1[e] = 0.f; u0[e] = 0.f; }
        if (s >= 1) { unpack8(*(const u32x4*)(pr - NP + 256), u1); unpack8(*(const u32x4*)(pr - NP + 512), xi);
#pragma unroll
            for (int e = 0; e < 8; ++e) u1[e] *= xi[e]; }
        if (s >= 2) { unpack8(*(const u32x4*)(pr - 2 * NP + 256), u0); unpack8(*(const u32x4*)(pr - 2 * NP + 512), xi);
#pragma unroll
            for (int e = 0; e < 8; ++e) u0[e] *= xi[e]; }
        float v[8];
#pragma unroll
        for (int e = 0; e < 8; ++e) v[e] = bg[e] * (cw[c0 + e] * u0[e] + cw[256 + c0 + e] * u1[e] + cw[512 + c0 + e] * u2[e]) * z[e];
        u32x4 w; w.x = cvtpk(v[0], v[1]); w.y = cvtpk(v[2], v[3]); w.z = cvtpk(v[4], v[5]); w.w = cvtpk(v[6], v[7]);
        *(u32x4*)(outs + (size_t)tok * DM + 256 + c0) = w; }
#pragma unroll 2
    for (long i = F.gtid; i < (long)TH * 16; i += F.GT) { const int g = (int)(i & 15); const int tok = (int)(i >> 4), b = tok >> 12, s = tok & 4095, ch = s >> 6, tt = s & 63;
        const u32x4* src = (const u32x4*)(proj + (size_t)tok * NP + C_S5U + g * 16);
        u32x4* dst = (u32x4*)(ux + ((size_t)g * 256 + b * 64 + ch) * 1152 + tt * 16);
        dst[0] = src[0]; dst[1] = src[1]; }
}
DI void p3_compress(const Ctx& F, const Args& a, int l, int half) {
    const bf16_t* proj = (const bf16_t*)(F.ws + WS_PROJ); const bf16_t* w1t = (const bf16_t*)(F.ws + WS_CW1T);
    const float* bias1 = (const float*)(F.ws + WS_CTL + 32768); const int* pos = (const int*)a.in[1];
    LAS float* part = (LAS float*)F.lds; LAS float* hbuf = (LAS float*)(F.lds + 32768);
    const int lane = F.lane, w = F.wave, fr = lane & 15, fq = lane >> 4;
    for (int item = blockIdx.x; item < 256; item += F.G) {
        const int j = item >> 7, rt = item & 127, lj = l * 2 + j;
        { int R = rt * 16 + fr; if (R > 2039) R = 2039; const int kh = R & 1, bn = R >> 1, n = bn % 255, b = bn / 255;
          const bf16_t* arow = proj + ((size_t)b * S + 16 * n) * NP + C_NKV + j * 128 + kh * 64;
          f32x4 acc[4];
#pragma unroll
          for (int q = 0; q < 4; ++q) acc[q] = (f32x4){0.f, 0.f, 0.f, 0.f};
#pragma unroll
          for (int ks = 0; ks < 8; ++ks) { const int lrow = 4 * w + (ks >> 1), d0 = (ks & 1) * 32 + 8 * fq;
              const bf16x8 av = *(const bf16x8*)(arow + (size_t)lrow * NP + d0);
#pragma unroll
              for (int q = 0; q < 4; ++q) { const bf16x8 bv = *(const bf16x8*)(w1t + ((size_t)lj * 64 + q * 16 + fr) * 2048 + 256 * w + 32 * ks + 8 * fq);
                  acc[q] = __builtin_amdgcn_mfma_f32_16x16x32_bf16(av, bv, acc[q], 0, 0, 0); } }
#pragma unroll
          for (int q = 0; q < 4; ++q)
#pragma unroll
              for (int e = 0; e < 4; ++e) part[(w * 16 + 4 * fq + e) * 64 + q * 16 + fr] = acc[q][e]; }
        __syncthreads();
        const int row = F.tid >> 5, op = F.tid & 31;
        { float s0 = 0.f, s1 = 0.f;
#pragma unroll
          for (int kc = 0; kc < 16; ++kc) { s0 += bias1[(lj * 16 + kc) * 64 + 2 * op]; s1 += bias1[(lj * 16 + kc) * 64 + 2 * op + 1]; }
#pragma unroll
          for (int ww = 0; ww < 8; ++ww) { s0 += part[(ww * 16 + row) * 64 + 2 * op]; s1 += part[(ww * 16 + row) * 64 + 2 * op + 1]; }
          hbuf[row * 64 + 2 * op] = s0 * sigm(s0); hbuf[row * 64 + 2 * op + 1] = s1 * sigm(s1); }
        __syncthreads();
        { const float* w2 = a.in[7] + (size_t)lj * 4096; float o0 = 0.f, o1 = 0.f;
          for (int o = 0; o < 64; ++o) { const float hv = hbuf[row * 64 + o]; o0 += hv * w2[o * 64 + 2 * op]; o1 += hv * w2[o * 64 + 2 * op + 1]; }
          const int R = rt * 16 + row; const bool valid = R < 2040; const int Rc = valid ? R : 2039; const int kh = Rc & 1, bn = Rc >> 1, n = bn % 255, b = bn / 255;
          if (j == 0) {
              float ss = o0 * o0 + o1 * o1;
#pragma unroll
              for (int o = 1; o < 32; o <<= 1) ss += __shfl_xor(ss, o);
              const float rs = __builtin_amdgcn_rsqf(ss * (1.f / 64.f) + EPS); const float* g1 = a.in[4] + l * 256 + 64;
              const float y0 = o0 * rs * g1[2 * op], y1 = o1 * rs * g1[2 * op + 1];
              const float p0 = __shfl_xor(y0, 16), p1 = __shfl_xor(y1, 16);
              const float ps = (float)pos[(half * NBH + b) * S + 16 * n + 31];
              const int i0 = (2 * op) & 31; float sn0, cs0, sn1, cs1;
              sincos_acc(ps * ex2(-(float)i0 * (13.287712379549449f / 32.f)), sn0, cs0); sincos_acc(ps * ex2(-(float)(i0 + 1) * (13.287712379549449f / 32.f)), sn1, cs1);
              float r0, r1; if (op < 16) { r0 = y0 * cs0 - p0 * sn0; r1 = y1 * cs1 - p1 * sn1; } else { r0 = y0 * cs0 + p0 * sn0; r1 = y1 * cs1 + p1 * sn1; }
              if (valid) { const int d = 2 * op; *(unsigned*)((bf16_t*)(F.ws + WS_KC) + ((size_t)b * 2 + kh) * 256 * 64 + (size_t)(n >> 6) * 4096 + ((((n >> 5) & 1) * 4 + (d >> 4)) * 64 + ((d >> 3) & 1) * 32 + (n & 31)) * 8 + (d & 7)) = cvtpk(r0, r1); }
          } else if (valid) { const int kk = n & 31; bf16_t* vb = (bf16_t*)(F.ws + WS_VCT) + ((size_t)b * 2 + kh) * 64 * 256 + (size_t)(n >> 6) * 4096 + ((kk >> 3) & 1) * 4 + (kk & 3);
              const int frag = (((n >> 5) & 1) * 2 + (kk >> 4)) * 2, hh = (kk >> 2) & 1;
              { const int d = 2 * op;     vb[((frag + (d >> 5)) * 64 + hh * 32 + (d & 31)) * 8] = f2bf(o0); }
              { const int d = 2 * op + 1; vb[((frag + (d >> 5)) * 64 + hh * 32 + (d & 31)) * 8] = f2bf(o1); } }
        }
        __syncthreads();
    }
}

DI f32x16 mfma32(bf16x8 a, bf16x8 b, f32x16 c) { return __builtin_amdgcn_mfma_f32_32x32x16_bf16(a, b, c, 0, 0, 0); }
DI f32x16 zero16() { f32x16 z;
#pragma unroll
    for (int i = 0; i < 16; ++i) z[i] = 0.f;
    return z; }
struct QF { bf16x8 q[4]; };
DI QF load_q(const bf16_t* Qrow  , int h) { QF f;
#pragma unroll
    for (int s = 0; s < 4; ++s) f.q[s] = *(const bf16x8*)(Qrow + 16 * s + 8 * h);
    return f; }
DI f32x16 qk_tile(const bf16_t* Kp  , int ldk, const QF& f, int r32, int h) {
    f32x16 st = zero16(); const bf16_t* kr = Kp + (size_t)r32 * ldk + 8 * h;
#pragma unroll
    for (int s = 0; s < 4; ++s) { const bf16x8 kf = *(const bf16x8*)(kr + 16 * s); st = mfma32(kf, f.q[s], st); }
    return st;
}
DI void pv_tile(f32x16 (&o)[2], const f32x16& p, const bf16_t* VTp  , int ldv, int r32, int h) {
#pragma unroll
    for (int s = 0; s < 2; ++s) {
        u32x4 pk; pk.x = cvtpk(p[8 * s + 0], p[8 * s + 1]); pk.y = cvtpk(p[8 * s + 2], p[8 * s + 3]); pk.z = cvtpk(p[8 * s + 4], p[8 * s + 5]); pk.w = cvtpk(p[8 * s + 6], p[8 * s + 7]);
        const bf16x8 pb = __builtin_bit_cast(bf16x8, pk);
#pragma unroll
        for (int dt = 0; dt < 2; ++dt) { const bf16_t* vr = VTp + (size_t)(dt * 32 + r32) * ldv + 16 * s + 4 * h;
            const s16x4 lo = *(const s16x4*)vr, hi = *(const s16x4*)(vr + 8);
            const bf16x8 va = __builtin_shufflevector(lo, hi, 0, 1, 2, 3, 4, 5, 6, 7);
            o[dt] = mfma32(va, pb, o[dt]); }
    }
}
struct KF { bf16x8 a[4], b[4]; };
DI KF load_k(const bf16_t* Kt  , int lane) { KF f; const bf16_t* kr = Kt + lane * 8;
#pragma unroll
    for (int s = 0; s < 4; ++s) { f.a[s] = *(const bf16x8*)(kr + s * 512); f.b[s] = *(const bf16x8*)(kr + 2048 + s * 512); }
    return f; }
DI void qk_from(const KF& k, const QF& f, f32x16& s0, f32x16& s1) { s0 = zero16(); s1 = zero16();
#pragma unroll
    for (int s = 0; s < 4; ++s) { s0 = mfma32(k.a[s], f.q[s], s0); s1 = mfma32(k.b[s], f.q[s], s1); } }
struct VF { bf16x8 v[8]; };
DI VF load_v(const bf16_t* Vt, int lane) { VF f; const bf16_t* vr = Vt + lane * 8;
#pragma unroll
    for (int i = 0; i < 8; ++i) f.v[i] = *(const bf16x8*)(vr + i * 512);
    return f; }
DI void pv_from(f32x16 (&o)[2], const f32x16& p0, const f32x16& p1, const VF& f) {
#pragma unroll
    for (int mt = 0; mt < 2; ++mt)
#pragma unroll
        for (int s = 0; s < 2; ++s) { const f32x16& p = mt ? p1 : p0;
            u32x4 pk; pk.x = cvtpk(p[8 * s + 0], p[8 * s + 1]); pk.y = cvtpk(p[8 * s + 2], p[8 * s + 3]); pk.z = cvtpk(p[8 * s + 4], p[8 * s + 5]); pk.w = cvtpk(p[8 * s + 6], p[8 * s + 7]);
            const bf16x8 pb = __builtin_bit_cast(bf16x8, pk);
#pragma unroll
            for (int dt = 0; dt < 2; ++dt) o[dt] = mfma32(f.v[(mt * 2 + s) * 2 + dt], pb, o[dt]); }
}
DI float score_bound(const float* gq, const float* gk, int lane) {
    float a = fabsf(gq[lane]), b = fabsf(gk[lane]);
#pragma unroll
    for (int o = 1; o < 64; o <<= 1) { a = fmaxf(a, __shfl_xor(a, o)); b = fmaxf(b, __shfl_xor(b, o)); }
    return 8.f * LOG2E * 1.02f * a * b + 0.05f;
}
DI void expsum_tile(f32x16& s0, f32x16& s1, const float M, float& l) {
    float ps = 0.f;
#pragma unroll
    for (int i = 0; i < 16; ++i) { s0[i] = ex2(s0[i] - M); s1[i] = ex2(s1[i] - M); ps += s0[i] + s1[i]; }
    l += ps;
}
constexpr float NEGB = -1e30f;
DI void softmax_tile(f32x16& s0, f32x16& s1, float& m, float& l, f32x16 (&o)[2]) {
    float tm = NEGB;
#pragma unroll
    for (int i = 0; i < 16; ++i) tm = fmaxf(tm, fmaxf(s0[i], s1[i]));
    tm = fmaxf(tm, __shfl_xor(tm, 32));
    const float mn = fmaxf(m, tm), mu = fmaxf(mn, -1e20f), alpha = ex2(fmaxf(m, -1e20f) - mu);
    const bool moved = mn != m; m = mn; float ps = 0.f;
#pragma unroll
    for (int i = 0; i < 16; ++i) { s0[i] = ex2(s0[i] - mu); s1[i] = ex2(s1[i] - mu); ps += s0[i] + s1[i]; }
    l = l * alpha + ps;
    if (__ballot(moved) != 0ull) { asm volatile("" ::: "memory");
#pragma unroll
        for (int i = 0; i < 16; ++i) { o[0][i] *= alpha; o[1][i] *= alpha; } }
}
#define KEY_OF(mt, i) (32 * (mt) + ((i) & 3) + 8 * ((i) >> 2) + 4 * h)

DI void attn_win(const Ctx& F, int b, int hq, int qblk, const float* qkg) {
    const int lane = F.lane, r32 = lane & 31, h = lane >> 5, kvh = hq >> 1, q0 = qblk * 32, tq = q0 + r32;
    const bf16_t* qn = (const bf16_t*)(F.ws + WS_QN); const bf16_t* kw = (const bf16_t*)(F.ws + WS_KW) + ((size_t)b * 2 + kvh) * S * 64;
    const bf16_t* vt = (const bf16_t*)(F.ws + WS_VTW) + ((size_t)b * 2 + kvh) * 64 * S;
    const QF qf = load_q(qn + ((size_t)b * S + tq) * 256 + hq * 64, h);
    f32x16 o[2] = {zero16(), zero16()}; float l = 0.f; const float M = score_bound(qkg, qkg + 192, lane);
    const int lo = q0 - 511 > 0 ? (q0 - 511) >> 6 : 0, hi = (q0 + 31) >> 6;
    KF kcur = load_k(kw + (size_t)lo * 4096, lane);
    for (int kt = lo; kt <= hi; ++kt) { const int key0 = kt * 64;
        const VF vf = load_v(vt + (size_t)kt * 4096, lane);
        const KF knxt = load_k(kw + (size_t)(kt < hi ? kt + 1 : kt) * 4096, lane);
        f32x16 s0, s1; qk_from(kcur, qf, s0, s1); kcur = knxt;
        if (key0 + 63 > q0 || key0 <= q0 + 31 - 512) { int tqq = tq; asm volatile("" : "+v"(tqq));
#pragma unroll
            for (int i = 0; i < 16; ++i) { const int k0 = key0 + KEY_OF(0, i), k1 = key0 + KEY_OF(1, i);
                if (!(k0 <= tqq && k0 > tqq - 512)) s0[i] = NEGB; if (!(k1 <= tqq && k1 > tqq - 512)) s1[i] = NEGB; } }
        expsum_tile(s0, s1, M, l);
        pv_from(o, s0, s1, vf);
    }
    l += __shfl_xor(l, 32); const float inv = __builtin_amdgcn_rcpf(fmaxf(l, 1e-30f));
    bf16_t* ow = (bf16_t*)(F.ws + WS_OWIN) + ((size_t)b * S + tq) * 256 + hq * 64;
#pragma unroll
    for (int dt = 0; dt < 2; ++dt)
#pragma unroll
        for (int g4 = 0; g4 < 4; ++g4) { const int d0 = 32 * dt + 8 * g4 + 4 * h;
            *(u32x2*)(ow + d0) = (u32x2){cvtpk(o[dt][4 * g4] * inv, o[dt][4 * g4 + 1] * inv), cvtpk(o[dt][4 * g4 + 2] * inv, o[dt][4 * g4 + 3] * inv)}; }
}
DI void attn_slc(const Ctx& F, int b, int hq, int qblk, const float* qkg) {
    const int lane = F.lane, r32 = lane & 31, h = lane >> 5, kvh = hq >> 1, q0 = qblk * 32, tq = q0 + r32;
    const bf16_t* qn = (const bf16_t*)(F.ws + WS_QN); const bf16_t* ks = (const bf16_t*)(F.ws + WS_KS) + ((size_t)b * 2 + kvh) * S * 64;
    const bf16_t* vt = (const bf16_t*)(F.ws + WS_VTS) + ((size_t)b * 2 + kvh) * 64 * S;
    const unsigned long long mk = ((const unsigned long long*)(F.ws + WS_SEL))[((size_t)b * S + tq) * 2 + kvh];
    const QF qf = load_q(qn + ((size_t)b * S + tq) * 256 + hq * 64, h);
    f32x16 o[2] = {zero16(), zero16()}; float l = 0.f; const float M = score_bound(qkg, qkg + 128, lane);
    if (qblk >= 96) __builtin_amdgcn_s_setprio(2); else if (qblk >= 48) __builtin_amdgcn_s_setprio(1);
    const int hi = (q0 + 31) >> 6;
    unsigned ulo = (unsigned)mk, uhi = (unsigned)(mk >> 32);
#pragma unroll
    for (int o_ = 1; o_ < 64; o_ <<= 1) { ulo |= (unsigned)__shfl_xor((int)ulo, o_); uhi |= (unsigned)__shfl_xor((int)uhi, o_); }
    unsigned long long rem = ((unsigned long long)(unsigned)__builtin_amdgcn_readfirstlane((int)uhi) << 32) | (unsigned)__builtin_amdgcn_readfirstlane((int)ulo);
    rem &= (hi >= 63) ? ~0ull : ((1ull << (hi + 1)) - 1ull);
    KF kcur = load_k(ks + (size_t)__builtin_ctzll(rem) * 4096, lane);
    while (rem) { const int kt = __builtin_ctzll(rem); rem &= rem - 1ull; const int key0 = kt * 64; const bool bit = (mk >> kt) & 1ull;
        const VF vf = load_v(vt + (size_t)kt * 4096, lane);
        const KF knxt = load_k(ks + (size_t)(rem ? __builtin_ctzll(rem) : kt) * 4096, lane);
        f32x16 s0, s1; qk_from(kcur, qf, s0, s1); kcur = knxt;
        const bool diag = key0 + 63 > q0;
        if (diag) { int tqq = tq; asm volatile("" : "+v"(tqq));
#pragma unroll
            for (int i = 0; i < 16; ++i) { const int k0 = key0 + KEY_OF(0, i), k1 = key0 + KEY_OF(1, i); s0[i] = k0 > tqq ? NEGB : s0[i]; s1[i] = k1 > tqq ? NEGB : s1[i]; } }
        if (__ballot(!bit) != 0ull) { float ng = NEGB; asm volatile("" : "+v"(ng));
#pragma unroll
            for (int i = 0; i < 16; ++i) { s0[i] = bit ? s0[i] : ng; s1[i] = bit ? s1[i] : ng; } }
        expsum_tile(s0, s1, M, l);
        pv_from(o, s0, s1, vf);
    }
    __builtin_amdgcn_s_setprio(0);
    l += __shfl_xor(l, 32); const float inv = __builtin_amdgcn_rcpf(fmaxf(l, 1e-30f));
    const size_t tok = (size_t)b * S + tq;
    const float* g12 = (const float*)(F.ws + WS_G12) + tok * 12; const float gc = g12[hq], gs = g12[4 + hq] * inv, gw = g12[8 + hq];
    const bf16_t* oc = (const bf16_t*)(F.ws + WS_OCMP) + tok * 256 + hq * 64; const bf16_t* ow = (const bf16_t*)(F.ws + WS_OWIN) + tok * 256 + hq * 64;
    const bf16_t* zz = (const bf16_t*)(F.ws + WS_PROJ) + tok * NP + C_NZ + hq * 64; bf16_t* outs = (bf16_t*)(F.ws + WS_OUTS) + tok * DM + hq * 64;
#pragma unroll
    for (int dt = 0; dt < 2; ++dt)
#pragma unroll
        for (int g4 = 0; g4 < 4; ++g4) { const int d0 = 32 * dt + 8 * g4 + 4 * h; float c4[4], w4[4], z4[4], v[4];
            unpack4(*(const u32x2*)(oc + d0), c4); unpack4(*(const u32x2*)(ow + d0), w4); unpack4(*(const u32x2*)(zz + d0), z4);
#pragma unroll
            for (int e = 0; e < 4; ++e) v[e] = (gc * c4[e] + gs * o[dt][4 * g4 + e] + gw * w4[e]) * z4[e];
            *(u32x2*)(outs + d0) = (u32x2){cvtpk(v[0], v[1]), cvtpk(v[2], v[3])}; }
}
DI void attn_sb(const Ctx& F, int b, int hq, int qblk) {
    const int lane = F.lane, r32 = lane & 31, h = lane >> 5, q0 = qblk * 32, tq = q0 + r32;
    const bf16_t* proj = (const bf16_t*)(F.ws + WS_PROJ) + (size_t)b * S * NP;
    const bf16_t* kp = (const bf16_t*)(F.ws + WS_KB) + ((size_t)b * 4 + hq) * S * 64; const bf16_t* vt = (const bf16_t*)(F.ws + WS_VTB) + ((size_t)b * 4 + hq) * 64 * S;
    const QF qf = load_q(proj + (size_t)tq * NP + C_SB + hq * 64, h);
    if (qblk >= 96) __builtin_amdgcn_s_setprio(3); else if (qblk >= 64) __builtin_amdgcn_s_setprio(2); else if (qblk >= 32) __builtin_amdgcn_s_setprio(1);
    f32x16 o[2] = {zero16(), zero16()}; float carry = 1.f;
    KF kcur = load_k(kp + (size_t)((q0 + 31) >> 6) * 4096, lane);
    for (int kt = (q0 + 31) >> 6; kt >= 0; --kt) { const int key0 = kt * 64;
        const VF vf = load_v(vt + (size_t)kt * 4096, lane);
        const KF knxt = load_k(kp + (size_t)(kt > 0 ? kt - 1 : kt) * 4096, lane);
        f32x16 s0, s1; qk_from(kcur, qf, s0, s1); kcur = knxt;
        const bool diag = key0 + 63 >= q0;
        f32x16 u0, u1;
#pragma unroll
        for (int i = 0; i < 16; ++i) {
            const float e0 = ex2(__builtin_amdgcn_fmed3f(s0[i], -126.f, 80.f)), e1 = ex2(__builtin_amdgcn_fmed3f(s1[i], -126.f, 80.f));
            const float a0_ = __builtin_amdgcn_rcpf(1.f + e0), a1_ = __builtin_amdgcn_rcpf(1.f + e1);
            u0[i] = a0_; u1[i] = a1_; s0[i] = e0 * a0_; s1[i] = e1 * a1_; }
        if (diag) { int tqq = tq; asm volatile("" : "+v"(tqq));
#pragma unroll
            for (int i = 0; i < 16; ++i) { const bool m0 = key0 + KEY_OF(0, i) >= tqq, m1 = key0 + KEY_OF(1, i) >= tqq;
                u0[i] = m0 ? 1.f : u0[i]; s0[i] = m0 ? 0.f : s0[i]; u1[i] = m1 ? 1.f : u1[i]; s1[i] = m1 ? 0.f : s1[i]; } }
        float G[8], R[8];
#pragma unroll
        for (int g4 = 0; g4 < 4; ++g4) { G[g4] = (u0[4 * g4] * u0[4 * g4 + 1]) * (u0[4 * g4 + 2] * u0[4 * g4 + 3]); G[4 + g4] = (u1[4 * g4] * u1[4 * g4 + 1]) * (u1[4 * g4 + 2] * u1[4 * g4 + 3]); }
#pragma unroll
        for (int q = 0; q < 8; ++q) R[q] = __shfl_xor(G[q], 32);
        float after = carry;
#pragma unroll
        for (int q = 7; q >= 0; --q) {
            float c = after * (h == 0 ? R[q] : 1.f);
            if (q < 4) { const int g4 = q;
#pragma unroll
                for (int e = 3; e >= 0; --e) { const float w = s0[4 * g4 + e] * c; c *= u0[4 * g4 + e]; s0[4 * g4 + e] = w; } }
            else { const int g4 = q - 4;
#pragma unroll
                for (int e = 3; e >= 0; --e) { const float w = s1[4 * g4 + e] * c; c *= u1[4 * g4 + e]; s1[4 * g4 + e] = w; } }
            after *= G[q] * R[q]; }
        carry = after;
        pv_from(o, s0, s1, vf);
    }
    __builtin_amdgcn_s_setprio(0);
    const size_t tok = (size_t)b * S + tq;
    const bf16_t* zz = (const bf16_t*)(F.ws + WS_PROJ) + tok * NP + C_SBZ + hq * 64; bf16_t* outs = (bf16_t*)(F.ws + WS_OUTS) + tok * DM + 512 + hq * 64;
#pragma unroll
    for (int dt = 0; dt < 2; ++dt)
#pragma unroll
        for (int g4 = 0; g4 < 4; ++g4) { const int d0 = 32 * dt + 8 * g4 + 4 * h; float z4[4]; unpack4(*(const u32x2*)(zz + d0), z4);
            *(u32x2*)(outs + d0) = (u32x2){cvtpk(o[dt][4 * g4] * z4[0], o[dt][4 * g4 + 1] * z4[1]), cvtpk(o[dt][4 * g4 + 2] * z4[2], o[dt][4 * g4 + 3] * z4[3])}; }
}
DI void attn_cmp(const Ctx& F, int b, int kvh, int qblk, int itag) {
    const int lane = F.lane, r32 = lane & 31, h = lane >> 5, q0 = qblk * 32, tq = q0 + r32;
    const bf16_t* qn = (const bf16_t*)(F.ws + WS_QN); const bf16_t* kc = (const bf16_t*)(F.ws + WS_KC) + ((size_t)b * 2 + kvh) * 256 * 64;
    const bf16_t* vt = (const bf16_t*)(F.ws + WS_VCT) + ((size_t)b * 2 + kvh) * 64 * 256;
    const int ntile = ((q0 >> 4) >> 6) + 1; const int nlim = (tq - 31) >> 4, nlim0 = (q0 - 31) >> 4;
    LAS float* ib = (LAS float*)(F.lds + F.wave * 8192);
#pragma unroll
    for (int t = 0; t < 32; ++t) ib[r32 * 64 + 2 * t + h] = 0.f;
#pragma unroll 1
    for (int g = 0; g < 2; ++g) { const int hq = kvh * 2 + g;
        const QF qf = load_q(qn + ((size_t)b * S + tq) * 256 + hq * 64, h);
        float m = NEGB, l = 0.f;
        KF kcur = load_k(kc, lane);
#pragma unroll 1
        for (int kt = 0; kt < ntile; ++kt) { const int key0 = kt * 64;
            const KF knxt = load_k(kc + (size_t)(kt + 1 < ntile ? kt + 1 : kt) * 4096, lane);
            f32x16 s0, s1; qk_from(kcur, qf, s0, s1); kcur = knxt;
            float tm = NEGB;
            if (key0 + 63 > nlim0) { int nl = nlim; asm volatile("" : "+v"(nl));
#pragma unroll
                for (int i = 0; i < 16; ++i) { if (key0 + KEY_OF(0, i) > nl) s0[i] = NEGB; if (key0 + KEY_OF(1, i) > nl) s1[i] = NEGB; } }
#pragma unroll
            for (int i = 0; i < 16; ++i) tm = fmaxf(tm, fmaxf(s0[i], s1[i]));
            tm = fmaxf(tm, __shfl_xor(tm, 32));
            const float mn = fmaxf(m, tm), mu = fmaxf(mn, -1e20f); float ps = 0.f;
#pragma unroll
            for (int i = 0; i < 16; ++i) ps += ex2(s0[i] - mu) + ex2(s1[i] - mu);
            l = l * ex2(fmaxf(m, -1e20f) - mu) + ps; m = mn; }
        l += __shfl_xor(l, 32); const float inv = __builtin_amdgcn_rcpf(fmaxf(l, 1e-30f)), mu = fmaxf(m, -1e20f);
        f32x16 o[2] = {zero16(), zero16()}; float prevlast = 0.f;
        kcur = load_k(kc, lane);
#pragma unroll 1
        for (int kt = 0; kt < ntile; ++kt) { const int key0 = kt * 64;
            const VF vf = load_v(vt + (size_t)kt * 4096, lane);
            const KF knxt = load_k(kc + (size_t)(kt + 1 < ntile ? kt + 1 : kt) * 4096, lane);
            f32x16 s0, s1; qk_from(kcur, qf, s0, s1); kcur = knxt;
#pragma unroll
            for (int i = 0; i < 16; ++i) { s0[i] = ex2(s0[i] - mu) * inv; s1[i] = ex2(s1[i] - mu) * inv; }
            if (key0 + 63 > nlim0) { int nl = nlim; asm volatile("" : "+v"(nl));
#pragma unroll
                for (int i = 0; i < 16; ++i) { if (key0 + KEY_OF(0, i) > nl) s0[i] = 0.f; if (key0 + KEY_OF(1, i) > nl) s1[i] = 0.f; } }
            float R[8];
#pragma unroll
            for (int g4 = 0; g4 < 4; ++g4) { R[g4] = __shfl_xor(s0[4 * g4 + 3], 32); R[4 + g4] = __shfl_xor(s1[4 * g4 + 3], 32); }
#pragma unroll
            for (int q = 0; q < 8; ++q) { float gs = (q < 4) ? (s0[4 * q] + s0[4 * q + 1]) + (s0[4 * q + 2] + s0[4 * q + 3]) : (s1[4 * (q - 4)] + s1[4 * (q - 4) + 1]) + (s1[4 * (q - 4) + 2] + s1[4 * (q - 4) + 3]);
                const float ex = (h == 1) ? R[q] : (q == 0 ? prevlast : R[q - 1]);
                ib[r32 * 64 + 16 * kt + 2 * q + h] += gs + ex; }
            prevlast = R[7];
            pv_from(o, s0, s1, vf); }
        bf16_t* oc = (bf16_t*)(F.ws + WS_OCMP) + ((size_t)b * S + tq) * 256 + hq * 64;
#pragma unroll
        for (int dt = 0; dt < 2; ++dt)
#pragma unroll
            for (int g4 = 0; g4 < 4; ++g4) { const int d0 = 32 * dt + 8 * g4 + 4 * h;
                *(u32x2*)(oc + d0) = (u32x2){cvtpk(o[dt][4 * g4], o[dt][4 * g4 + 1]), cvtpk(o[dt][4 * g4 + 2], o[dt][4 * g4 + 3])}; }
    }
    LDS_WAIT();
    unsigned long long* sel = (unsigned long long*)(F.ws + WS_SEL);
#pragma unroll 1
    for (int qq = 0; qq < 32; qq += 8) {
        unsigned key[8], prefix[8];
#pragma unroll
        for (int u = 0; u < 8; ++u) { const int t = q0 + qq + u, cur = t >> 6, j = lane;
            const float v = ib[(qq + u) * 64 + lane];
            const float val = (j == 0 || j == cur || j == cur - 1) ? 1.0e4f : (j <= cur ? v : -1.0e4f);
            const unsigned vb_ = __float_as_uint(val); key[u] = vb_ ^ ((vb_ >> 31) ? 0xFFFFFFFFu : 0x80000000u); prefix[u] = 0u; }
#pragma unroll 1
        for (int bit = 31; bit >= 0; --bit) {
#pragma unroll
            for (int u = 0; u < 8; ++u) { const unsigned cand = prefix[u] | (1u << bit); if (__popcll(__ballot(key[u] >= cand)) >= 16) prefix[u] = cand; } }
#pragma unroll
        for (int u = 0; u < 8; ++u) { const int t = q0 + qq + u;
            unsigned long long mk = __ballot(key[u] > prefix[u]), eq = __ballot(key[u] == prefix[u]); int need = 16 - (int)__popcll(mk);
            while (need-- > 0) { const unsigned long long lb = eq & (0ull - eq); mk |= lb; eq ^= lb; }
            if (lane == 0) sel[((size_t)b * S + t) * 2 + kvh] = mk; } }
    LDS_WAIT();
    (void)itag;
}
DI int grab(unsigned* ctr, int lane) { int v = 0; if (lane == 0) v = (int)atomicAdd(ctr, 1u); return __builtin_amdgcn_readfirstlane(v); }

DI void s5_scan(const Ctx& F, int l, int g) {
    VM_WAIT(); __syncthreads();
    if (F.tid < 256) { const int b = F.tid >> 6, p = F.tid & 63; const f32x2 a64 = ((const f32x2*)(F.ws + WS_POW))[((size_t)(l * 16 + g) * 64 + p) * 65 + 64];
        const float* stl = (const float*)(F.ws + WS_STL) + ((size_t)g * 256 + b * 64) * 128 + p; bf16_t* ux = (bf16_t*)(F.ws + WS_UX) + ((size_t)g * 256 + b * 64) * 1152 + 1024 + p;
        float xr = 0.f, xi = 0.f;
#pragma unroll 1
        for (int c0 = 0; c0 < 64; c0 += 16) { float lr[16], li[16];
#pragma unroll
            for (int j = 0; j < 16; ++j) { lr[j] = stl[(size_t)(c0 + j) * 128]; li[j] = stl[(size_t)(c0 + j) * 128 + 64]; }
#pragma unroll
            for (int j = 0; j < 16; ++j) { ux[(size_t)(c0 + j) * 1152] = f2bf(xr); ux[(size_t)(c0 + j) * 1152 + 64] = f2bf(xi);
                const float nr = a64.x * xr - a64.y * xi + lr[j], ni = a64.x * xi + a64.y * xr + li[j]; xr = nr; xi = ni; } } }
    VM_WAIT(); __syncthreads();
}

#if !defined(ONLY_ATT) || ONLY_ATT==0
#define ATT0(x) x
#else
#define ATT0(x) do{}while(0)
#endif
#if !defined(ONLY_ATT) || ONLY_ATT==1
#define ATT1(x) x
#else
#define ATT1(x) do{}while(0)
#endif
#if !defined(ONLY_ATT) || ONLY_ATT==2
#define ATT2(x) x
#else
#define ATT2(x) do{}while(0)
#endif
#if !defined(ONLY_ATT) || ONLY_ATT==3
#define ATT3(x) x
#else
#define ATT3(x) do{}while(0)
#endif
#if !defined(NO_GEMM) && (!defined(ONLY_GEMM) || ONLY_GEMM==0)
#define GEMM_CALL0(a,b,c,d) pg8::gemm_phase<C>(a,b,c,d)
#else
#define GEMM_CALL0(a,b,c,d) do{}while(0)
#endif
#if !defined(NO_GEMM) && (!defined(ONLY_GEMM) || ONLY_GEMM==1)
#define GEMM_CALL1(a,b,c,d) pg8::gemm_phase<C>(a,b,c,d)
#else
#define GEMM_CALL1(a,b,c,d) do{}while(0)
#endif
#if !defined(NO_GEMM) && (!defined(ONLY_GEMM) || ONLY_GEMM==2)
#define GEMM_CALL2(a,b,c,d) pg8::gemm_phase<C>(a,b,c,d)
#else
#define GEMM_CALL2(a,b,c,d) do{}while(0)
#endif
#if !defined(NO_GEMM) && (!defined(ONLY_GEMM) || ONLY_GEMM==3)
#define GEMM_CALL3(a,b,c,d) pg8::gemm_phase<C>(a,b,c,d)
#else
#define GEMM_CALL3(a,b,c,d) do{}while(0)
#endif
#if !defined(NO_GEMM) && (!defined(ONLY_GEMM) || ONLY_GEMM==4)
#define GEMM_CALL4(a,b,c,d) pg8::gemm_phase<C>(a,b,c,d)
#else
#define GEMM_CALL4(a,b,c,d) do{}while(0)
#endif
#if !defined(NO_GEMM) && (!defined(ONLY_GEMM) || ONLY_GEMM==5)
#define GEMM_CALL5(a,b,c,d) pg8::gemm_phase<C>(a,b,c,d)
#else
#define GEMM_CALL5(a,b,c,d) do{}while(0)
#endif
__global__ void __launch_bounds__(NTHR, 2) mega(Args a) {
    extern __shared__ __attribute__((aligned(16))) unsigned char lds_raw[];
    cg::grid_group grid = cg::this_grid();
#define MKCTX() Ctx F = mkctx(a.ws, (LAS unsigned char*)lds_raw)
    unsigned char* ws = a.ws; unsigned* ctl = (unsigned*)(ws + WS_CTL);
    const int c = blockIdx.x, G = gridDim.x;
    if (threadIdx.x < 8) ((volatile LAS unsigned*)(lds_raw + MISC_OFF))[threadIdx.x] = 0u;
    __syncthreads();
    const XcdBarrier xbar = xcd_barrier_post(ctl + CW_BAR, (volatile LAS unsigned*)((LAS unsigned char*)lds_raw + MISC_OFF));
#define GSYNC() xcd_barrier(xbar)
#define LDSP ((LAS unsigned char*)lds_raw)

#ifndef NO_K1
    { MKCTX(); k1_prologue(F, a); }
#endif
    grid.sync();
    for (int l = 0; l < 2; ++l) {
        for (int half = 0; half < 2; ++half) {
            const float* xin = (l == 0 ? a.in[0] : a.out) + (size_t)half * TH * DM; float* xout = a.out + (size_t)half * TH * DM;
#ifndef NO_P1
            { MKCTX(); if (l == 0 && half == 0) kmat_build(F, a);
            p1_pre(F, xin, l); }
#endif
            GSYNC();
            { using C = pg8::Cfg<DM, DM, DM, 0, 0, TH / 256, NINP / 256, 1, 0>;
              pg8::Gemm g{(const bf16_t*)(ws + WS_XB), (const bf16_t*)(ws + WS_WINT) + (size_t)l * NINP * DM};
              pg8::Sched<C> Sc{G, c};
              EpiInproj E{ws};
              GEMM_CALL0(LDSP, g, Sc, E); }
            GSYNC();
#ifndef NO_P3
            { MKCTX(); p3_compress(F, a, l, half); }
            { MKCTX(); p3_qk(F, a, l, half); }
            { MKCTX(); p3_vt(F); }
            { MKCTX(); p3_conv_relayout(F, a, l); }
            if (half == 0) { MKCTX(); s5_expand(F, a, l); }
#endif
            GSYNC();
            if (c < 16 && c < G) {
                { using C = pg8::Cfg<1152, 1024, 1024, 256 * 1152, 256 * 1024, 1, 1, 16, 0>;
                  pg8::Gemm g{(const bf16_t*)(ws + WS_UX), (const bf16_t*)(ws + WS_SPG)};
                  pg8::Sched<C> Sc{16 > G ? G : 16, c};
                  EpiS5a E{ws}; GEMM_CALL1(LDSP, g, Sc, E); }
                { MKCTX(); s5_scan(F, l, c); }
            }
            { MKCTX(); const int x0 = (int)(xb_xcc_id() & 7u);
              for (int qi = 0; qi < 8; ++qi) { const int xq = (x0 + qi) & 7; unsigned* ctr = ctl + 64 * ((((l * 2 + half) * 2 + 0) * 8) + xq); const int b = xq >> 1, kvh = xq & 1;
                  for (;;) { const int idx = grab(ctr, F.lane); if (idx >= 128 + 256) break;
                      if (idx < 128) { ATT2(attn_cmp(F, b, kvh, 127 - idx, 0)); }
                      else { const int i3 = idx - 128; ATT1(attn_win(F, b, kvh * 2 + (i3 & 1), i3 >> 1, a.in[4] + l * 256)); }
                  } } }
            GSYNC();
            { using C = pg8::Cfg<1152, 1152, 1152, 256 * 1152, 1024 * 1152, 1, 4, 16, 0>;
              pg8::Gemm g{(const bf16_t*)(ws + WS_UX), (const bf16_t*)(ws + WS_SA2)};
              pg8::Sched<C> Sc{64 > G ? G : 64, c};
              if (c < Sc.G) { EpiS5b E{ws}; GEMM_CALL2(LDSP, g, Sc, E); } }
            { MKCTX(); const int x0 = (int)(xb_xcc_id() & 7u);
              for (int qi = 0; qi < 8; ++qi) { const int xq = (x0 + qi) & 7; unsigned* ctr = ctl + 64 * ((((l * 2 + half) * 2 + 1) * 8) + xq); const int b = xq >> 1, kvh = xq & 1;
                  for (;;) { const int idx = grab(ctr, F.lane); if (idx >= 512) break;
                      const int qb = 127 - (idx >> 2), hq = kvh * 2 + (idx & 1);
                      if (idx & 2) { ATT3(attn_slc(F, b, hq, qb, a.in[4] + l * 256)); } else { ATT0(attn_sb(F, b, hq, qb)); }
                  } } }
            GSYNC();
            { using C = pg8::Cfg<256, 256, 256, 0, 0, TH / 256, 2, 1, 0>;
              pg8::Gemm g{(const bf16_t*)(ws + WS_Y5), (const bf16_t*)(ws + WS_GLUT) + (size_t)l * 512 * 256};
              pg8::Sched<C> Sc{G, c};
              EpiGlu E{ws, a.in[18] + l * 512};
              GEMM_CALL3(LDSP, g, Sc, E); }
            GSYNC();
            { using C = pg8::Cfg<DM, 512, 512, 512, 8 * 256 * 512, TH / 256, 8, 2, 1, true>;
              pg8::Gemm g{(const bf16_t*)(ws + WS_OUTS), (const bf16_t*)(ws + WS_WB2T) + (size_t)l * 2 * 8 * 256 * 512};
              pg8::Sched<C> Sc{G, c};
              EpiBranch E{ws};
              GEMM_CALL4(LDSP, g, Sc, E); }
            GSYNC();
            { using C = pg8::Cfg<DM, DM, DM, 0, 0, TH / 256, 4, 1, 0>;
              pg8::Gemm g{(const bf16_t*)(ws + WS_MIXED), (const bf16_t*)(ws + WS_WOUTT) + (size_t)l * DM * DM};
              pg8::Sched<C> Sc{G, c};
              EpiOut E{xin, xout};
              GEMM_CALL5(LDSP, g, Sc, E); }
            GSYNC();
        }
    }
}

extern "C" void kernel_launch(void* const* d_in, const int* in_sizes, int n_in, void* d_out, int out_size, void* d_ws, size_t ws_size, hipStream_t stream) {
    static int grid = 0;
    if (grid == 0) {
        if (n_in != 21 || ws_size < WS_END) { fprintf(stderr, "kernel_launch: unexpected n_in %d / ws_size %zu (need %zu)\n", n_in, ws_size, (size_t)WS_END); grid = -1; return; }
        int dev = 0, cus = 0, per_cu = 0;
        hipGetDevice(&dev); hipDeviceGetAttribute(&cus, hipDeviceAttributeMultiprocessorCount, dev);
        hipFuncSetAttribute((const void*)mega, hipFuncAttributeMaxDynamicSharedMemorySize, LDS_BYTES);
        hipOccupancyMaxActiveBlocksPerMultiprocessor(&per_cu, (const void*)mega, NTHR, LDS_BYTES);
        if (per_cu < 1) { fprintf(stderr, "kernel_launch: occupancy query says %d blocks per CU\n", per_cu); per_cu = 1; }
        grid = cus * 1;
        (void)hipGetLastError();
    }
    if (grid < 0) return;
    hipMemsetAsync((char*)d_ws + WS_CTL, 0, CTL_BYTES, stream);
    Args a{};
    for (int i = 0; i < 21; ++i) a.in[i] = (const float*)d_in[i];
    a.out = (float*)d_out; a.ws = (unsigned char*)d_ws;
    void* params[] = {&a};
    hipError_t e = hipLaunchCooperativeKernel((const void*)mega, dim3(grid), dim3(NTHR), params, LDS_BYTES, stream);
    if (e != hipSuccess) fprintf(stderr, "cooperative launch failed: %s (grid %d)\n", hipGetErrorString(e), grid);
}
```
